# Optimizing an MI355X kernel written in HIP

```python
import math
import jax, jax.numpy as jnp
from jax import lax
import numpy as np

D_MODEL = 4096
BATCH = 4
SEQ = 2048
DEPTH = 2

CHUNK = 64
Q_BLOCK = 128
ATTN_HEAD_DIM = 128
ATTN_WIDTH = D_MODEL // 2
ATTN_HEADS = ATTN_WIDTH // ATTN_HEAD_DIM
SSM_WIDTH = D_MODEL // 2
SSM_GROUP = 16
SSM_GROUPS = SSM_WIDTH // SSM_GROUP
SSM_STATE = 64
D_FF = 4 * D_MODEL
PLE_DIM = 256
RMS_EPS = 1e-6
DT_MIN = 0.001
DT_MAX = 0.1
IN_WIDTH = 3 * ATTN_WIDTH + SSM_WIDTH + 2 * D_MODEL
SPLITS = [ATTN_WIDTH, 2 * ATTN_WIDTH, 3 * ATTN_WIDTH, 3 * ATTN_WIDTH + SSM_WIDTH,
          3 * ATTN_WIDTH + SSM_WIDTH + D_MODEL]

kernel_name = "hybrid_stickbreak_s5_gated_trunk"


def rmsnorm(x, g):
    xf = x.astype(jnp.float32)
    y = xf * lax.rsqrt(jnp.mean(xf * xf, axis=-1, keepdims=True) + RMS_EPS)
    return (y * g.astype(jnp.float32)).astype(x.dtype)


def stick_breaking_attention(q, k, v):
    b, s, h, dh = q.shape
    nb = s // Q_BLOCK
    scale = dh ** -0.5
    kf = k.astype(jnp.float32)
    vf = v.astype(jnp.float32)
    qb = q.astype(jnp.float32).reshape(b, nb, Q_BLOCK, h, dh).transpose(1, 0, 2, 3, 4)
    key_pos = jnp.arange(s)

    def block(args):
        q_blk, blk = args
        q_pos = blk * Q_BLOCK + jnp.arange(Q_BLOCK)
        mask = key_pos[None, :] < q_pos[:, None]
        z = jnp.einsum('bqhd,bkhd->bhqk', q_blk, kf) * scale
        log_beta = jax.nn.log_sigmoid(z)
        log_1m = jnp.where(mask, jax.nn.log_sigmoid(-z), 0.0)
        tail = lax.cumsum(log_1m, axis=3, reverse=True) - log_1m
        w = jnp.where(mask, jnp.exp(log_beta + tail), 0.0)
        return jnp.einsum('bhqk,bkhd->bqhd', w, vf)

    out = lax.map(block, (qb, jnp.arange(nb)))
    return out.transpose(1, 0, 2, 3, 4).reshape(b, s, h, dh).astype(q.dtype)


def s5_ssm(u, lam_re, lam_im, log_dt, b_re, b_im, c_re, c_im, d_skip):
    bsz, s, w = u.shape
    f32 = jnp.float32
    uf = u.astype(f32).reshape(bsz, s, SSM_GROUPS, SSM_GROUP)
    lam = lax.complex(lam_re.astype(f32), lam_im.astype(f32))
    dt = jnp.exp(log_dt.astype(f32))[:, None]
    lam_bar = jnp.exp(lam * dt)
    bmat = lax.complex(b_re.astype(f32), b_im.astype(f32))
    b_bar = ((lam_bar - 1.0) / lam)[..., None] * bmat
    cmat = lax.complex(c_re.astype(f32), c_im.astype(f32))
    bu = jnp.einsum('bsgc,gpc->sbgp', uf.astype(jnp.complex64), b_bar)
    a = jnp.broadcast_to(lam_bar[None, None], (s, 1, SSM_GROUPS, SSM_STATE))

    def combine(e1, e2):
        a1, x1 = e1
        a2, x2 = e2
        return a1 * a2, a2 * x1 + x2

    _, states = lax.associative_scan(combine, (a, bu), axis=0)
    y = jnp.einsum('sbgp,gcp->bsgc', states, cmat).real
    y = y + d_skip.astype(f32).reshape(SSM_GROUPS, SSM_GROUP) * uf
    return y.reshape(bsz, s, w).astype(u.dtype)


def setup_inputs(seed: int = 0) -> dict:
    key = jax.random.key(seed)
    ks = jax.random.split(key, 24)
    nrm = jax.random.normal
    L = DEPTH
    G, P, C = SSM_GROUPS, SSM_STATE, SSM_GROUP
    return {
        "x": nrm(ks[0], (BATCH, SEQ, D_MODEL), jnp.float32),
        "p": nrm(ks[1], (L, BATCH, SEQ, PLE_DIM), jnp.float32),
        "g_mix": 1.0 + 0.02 * nrm(ks[2], (L, D_MODEL), jnp.float32),
        "w_in": nrm(ks[3], (L, D_MODEL, IN_WIDTH), jnp.float32) * D_MODEL ** -0.5,
        "w_br_attn": nrm(ks[4], (L, ATTN_WIDTH, D_MODEL), jnp.float32) * ATTN_WIDTH ** -0.5,
        "lam_re": -0.5 + 0.01 * nrm(ks[5], (L, G, P), jnp.float32),
        "lam_im": math.pi * jnp.arange(P, dtype=jnp.float32)[None, None, :] + 0.01 * nrm(ks[6], (L, G, P), jnp.float32),
        "log_dt": jax.random.uniform(ks[7], (L, G), jnp.float32, math.log(DT_MIN), math.log(DT_MAX)),
        "b_re": nrm(ks[8], (L, G, P, C), jnp.float32) * (2.0 * C) ** -0.5,
        "b_im": nrm(ks[9], (L, G, P, C), jnp.float32) * (2.0 * C) ** -0.5,
        "c_re": nrm(ks[10], (L, G, C, P), jnp.float32) * (2.0 * P) ** -0.5,
        "c_im": nrm(ks[11], (L, G, C, P), jnp.float32) * (2.0 * P) ** -0.5,
        "d_skip": nrm(ks[12], (L, SSM_WIDTH), jnp.float32),
        "w_glu": nrm(ks[13], (L, SSM_WIDTH, SSM_WIDTH), jnp.float32) * SSM_WIDTH ** -0.5,
        "w_br_ssm": nrm(ks[14], (L, SSM_WIDTH, D_MODEL), jnp.float32) * SSM_WIDTH ** -0.5,
        "w_o": nrm(ks[15], (L, D_MODEL, D_MODEL), jnp.float32) * D_MODEL ** -0.5,
        "g_mlp": 1.0 + 0.02 * nrm(ks[16], (L, D_MODEL), jnp.float32),
        "w_ff1": nrm(ks[17], (L, D_MODEL, D_FF), jnp.float32) * D_MODEL ** -0.5,
        "w_ff2": nrm(ks[18], (L, D_FF, D_MODEL), jnp.float32) * D_FF ** -0.5,
        "g_ple": 1.0 + 0.02 * nrm(ks[19], (L, D_MODEL), jnp.float32),
        "w_ple_gate": nrm(ks[20], (L, D_MODEL, D_MODEL), jnp.float32) * D_MODEL ** -0.5,
        "w_ple": nrm(ks[21], (L, PLE_DIM, D_MODEL), jnp.float32) * PLE_DIM ** -0.5,
        "g_final": 1.0 + 0.02 * nrm(ks[22], (D_MODEL,), jnp.float32),
    }


def reference(x, p, g_mix, w_in, w_br_attn, lam_re, lam_im, log_dt, b_re, b_im,
              c_re, c_im, d_skip, w_glu, w_br_ssm, w_o, g_mlp, w_ff1, w_ff2,
              g_ple, w_ple_gate, w_ple, g_final):
    h = x
    bsz, s, _ = x.shape
    for i in range(DEPTH):
        xn = rmsnorm(h, g_mix[i])
        proj = xn @ w_in[i]
        q, k, v, u, g_a, g_s = jnp.split(proj, SPLITS, axis=-1)
        q = q.reshape(bsz, s, ATTN_HEADS, ATTN_HEAD_DIM)
        k = k.reshape(bsz, s, ATTN_HEADS, ATTN_HEAD_DIM)
        v = v.reshape(bsz, s, ATTN_HEADS, ATTN_HEAD_DIM)
        attn = stick_breaking_attention(q, k, v).reshape(bsz, s, ATTN_WIDTH)
        attn_up = attn @ w_br_attn[i]
        y = jax.nn.gelu(s5_ssm(u, lam_re[i], lam_im[i], log_dt[i], b_re[i], b_im[i],
                               c_re[i], c_im[i], d_skip[i]))
        ssm = y * jax.nn.sigmoid(y @ w_glu[i])
        ssm_up = ssm @ w_br_ssm[i]
        merged = jax.nn.sigmoid(g_a) * attn_up + jax.nn.sigmoid(g_s) * ssm_up
        h = h + merged @ w_o[i]
        hn = rmsnorm(h, g_mlp[i])
        h = h + jnp.square(jax.nn.relu(hn @ w_ff1[i])) @ w_ff2[i]
        gate = jax.nn.sigmoid(rmsnorm(h, g_ple[i]) @ w_ple_gate[i])
        h = h + (p[i] @ w_ple[i]) * gate
    return rmsnorm(h, g_final)
```

```cpp
#include <hip/hip_runtime.h>
#include <cstdio>
#include <cstdint>
namespace pg8 {
#define PG8_LAS __attribute__((address_space(3)))
typedef unsigned short bf16_t;
typedef short bf16x8 __attribute__((ext_vector_type(8)));
typedef float f32x4 __attribute__((ext_vector_type(4)));
typedef unsigned u32x4 __attribute__((ext_vector_type(4)));
typedef int i32x8 __attribute__((ext_vector_type(8)));
constexpr int BM = 256, BK = 64, HALF = 128, HTB = HALF * BK * 2  , STAGE_BYTES = 8 * HTB, NXCD = 8, WGM = 8;

__host__ __device__ __forceinline__ int lds_byte(int r, int c) { const int st = (r >> 4) * 2 + (c >> 5), rr = r & 15, cc = c & 31, ob = rr * 64 + cc * 2; return st * 1024 + (ob ^ (((ob >> 9) & 1) << 5)); }
__host__ __device__ __forceinline__ void stage_rc(int b, int& R, int& C) { const int st = b / 1024, sb = b % 1024, swz = sb ^ (((sb >> 9) & 1) << 5); R = (st >> 1) * 16 + swz / 64; C = (st & 1) * 32 + (swz % 64) / 2; }
__host__ __device__ __forceinline__ int perm32(int rho) { const int n = rho >> 4, i = rho & 15; return 8 * (i >> 2) + 4 * n + (i & 3); }

__device__ __forceinline__ int lane_id() { unsigned z = 0u; asm volatile("" : "+v"(z)); return (int)__builtin_amdgcn_mbcnt_hi(~0u, __builtin_amdgcn_mbcnt_lo(~0u, z)); }
struct Unit { int pm, pn; };
struct Gemm { const bf16_t* A; const bf16_t* Bt; int M, N, K; };
__host__ __device__ __forceinline__ size_t tix(int row, int col) { return ((size_t)(col >> 6) * 8192 + row) * 64 + (col & 63); }

struct StaticOrder {
    int nM, nN, nwg, G, c, ibeg, iend;
    __host__ __device__ void init(int M, int N, int G_, int c_) { nM = M / BM; nN = N / BM; nwg = nM * nN; G = G_; c = c_; ibeg = 0; iend = 0x7fffffff; }
    __host__ __device__ bool next(int i, Unit& u) const {
        i += ibeg; if (i >= iend) return false;
        const long L = (long)i * G + c; if (L >= nwg) return false;
        int wgid = (int)L; { const int q = nwg / NXCD, r = nwg % NXCD, xcd = wgid % NXCD, off = wgid / NXCD; wgid = (xcd < r ? xcd * (q + 1) : r * (q + 1) + (xcd - r) * q) + off; }
        const int nig = WGM * nN, gid = wgid / nig, fm = gid * WGM, gsz = (nM - fm) < WGM ? (nM - fm) : WGM;
        u.pm = fm + ((wgid % nig) % gsz); u.pn = (wgid % nig) / gsz; return true;
    }
    __device__ __forceinline__ void a_ready(const Unit&) const {}
    __device__ __forceinline__ void done(const Unit&) const {}
};

typedef float f32x2c __attribute__((ext_vector_type(2)));
typedef __bf16 bf16x2c __attribute__((ext_vector_type(2)));
__device__ __forceinline__ unsigned cvt_pk_bf16(float lo, float hi) { const f32x2c v = {lo, hi}; return __builtin_bit_cast(unsigned, __builtin_convertvector(v, bf16x2c)); }
typedef float f32x2 __attribute__((ext_vector_type(2)));
typedef unsigned u32x2 __attribute__((ext_vector_type(2)));
__device__ __forceinline__ float bf_lo(unsigned w) { return __uint_as_float(w << 16); }
__device__ __forceinline__ float bf_hi(unsigned w) { return __uint_as_float(w & 0xffff0000u); }
typedef unsigned long long ssq_t;
__device__ __forceinline__ ssq_t ss_enc(float s) { return (ssq_t)(s * 16777216.0f); }
__device__ __forceinline__ float ss_dec(ssq_t v) { return (float)v * (1.0f / 16777216.0f); }
__device__ __forceinline__ unsigned q8(float s) { return (unsigned)(s * 255.0f + 0.5f); }
__device__ __forceinline__ unsigned pack4q(float a, float b, float c, float d) { return q8(a) | (q8(b) << 8) | (q8(c) << 16) | (q8(d) << 24); }
constexpr float F8_ASCALE = 8.0f, F8_WSCALE = 512.0f, F8_UNSCALE = 1.0f / 4096.0f;
__device__ __forceinline__ unsigned pk4_fp8(float a, float b, float c, float d) { unsigned w = 0u; w = __builtin_amdgcn_cvt_pk_fp8_f32(a, b, w, false); w = __builtin_amdgcn_cvt_pk_fp8_f32(c, d, w, true); return w; }
__host__ __device__ __forceinline__ size_t tix8(int row, int col) { return ((size_t)(col >> 7) * 8192 + row) * 128 + (col & 127); }
__device__ __forceinline__ float sigm(float x) { return __builtin_amdgcn_rcpf(1.0f + __expf(-x)); }

struct EpiIn {
    static constexpr bool PERM = true, AFTER_DRAIN = false, FP8 = false;
    const ssq_t* ssin;
    PG8_LAS unsigned char* vlds;
    bf16_t* ACT;
    __device__ __forceinline__ void operator()(const f32x4 (&acc)[2][2][4][2], const Unit& u, int wr, int wc, int fr, int fq) const {
        const int colt = u.pn * BM, row0 = u.pm * BM + wr * 64 + fr;
        const int b = (u.pm * BM) >> 11, s00 = ((u.pm * BM) & 2047) + wr * 64;
        float rr[2][4];
#pragma unroll
        for (int ai = 0; ai < 2; ++ai)
#pragma unroll
            for (int m = 0; m < 4; ++m) rr[ai][m] = 1.0f / sqrtf(ss_dec(ssin[row0 + ai * HALF + m * 16]) * (1.0f / 4096.0f) + 1e-6f);
        if (colt >= 4096 && colt < 6144) {
            const int h0 = (colt - 4096) >> 7; const int lane = fq * 16 + fr, rv = lane & 31, hv = lane >> 5;
            PG8_LAS unsigned char* vt = vlds + (wr * 4 + wc) * 2048;
#pragma unroll
            for (int ai = 0; ai < 2; ++ai)
#pragma unroll
                for (int m = 0; m < 4; ++m) { const int t = (s00 + ai * HALF + m * 16) >> 5, sx = m & 1;
#pragma unroll
                    for (int bj = 0; bj < 2; ++bj) { const f32x4 v0 = acc[ai][bj][m][0] * rr[ai][m], v1 = acc[ai][bj][m][1] * rr[ai][m];
                        u32x4 w; w.x = cvt_pk_bf16(v0[0], v0[1]); w.y = cvt_pk_bf16(v0[2], v0[3]); w.z = cvt_pk_bf16(v1[0], v1[1]); w.w = cvt_pk_bf16(v1[2], v1[3]);
                        PG8_LAS unsigned char* tb = vt + ((m * 2 + bj) & 1) * 1024;
                        *(PG8_LAS u32x4*)(tb + fr * 64 + fq * 16) = w;
                        unsigned short q[8];
#pragma unroll
                        for (int j = 0; j < 8; ++j) q[j] = *(const PG8_LAS unsigned short*)(tb + ((j & 3) + 4 * hv + 8 * (j >> 2)) * 64 + rv * 2);
                        u32x4 o; o.x = q[0] | ((unsigned)q[1] << 16); o.y = q[2] | ((unsigned)q[3] << 16); o.z = q[4] | ((unsigned)q[5] << 16); o.w = q[6] | ((unsigned)q[7] << 16);
                        *(u32x4*)(ACT + ((size_t)2 << 24) + ((((size_t)((b * 16 + h0 + bj) * 64 + t) * 4 + wc) * 2 + sx) * 64 + lane) * 8) = o; } }
        } else if (colt >= 6144) {
            const int g0 = ((colt - 6144) >> 4) + 2 * wc + (fq >> 1), hu = fq & 1;
#pragma unroll
            for (int ai = 0; ai < 2; ++ai)
#pragma unroll
                for (int m = 0; m < 4; ++m) { const int chunk = (s00 + ai * HALF + m * 16) >> 4, mt = chunk >> 5, ru = chunk & 31;
#pragma unroll
                    for (int bj = 0; bj < 2; ++bj) { const f32x4 v0 = acc[ai][bj][m][0] * rr[ai][m], v1 = acc[ai][bj][m][1] * rr[ai][m];
                        u32x4 w; w.x = cvt_pk_bf16(v0[0], v0[1]); w.y = cvt_pk_bf16(v0[2], v0[3]); w.z = cvt_pk_bf16(v1[0], v1[1]); w.w = cvt_pk_bf16(v1[2], v1[3]);
                        *(u32x4*)(ACT + ((size_t)3 << 24) + ((((size_t)((b * 128 + g0 + 8 * bj) * 4 + mt) * 16 + fr) * 64) + hu * 32 + ru) * 8) = w; } }
        } else {
            bf16_t* base = ACT + ((size_t)(colt >> 11) << 24); const int h0 = (colt & 2047) >> 7, hq = wc >> 1, ks = 4 * (wc & 1) + fq;
#pragma unroll
            for (int ai = 0; ai < 2; ++ai)
#pragma unroll
                for (int m = 0; m < 4; ++m) { const int t = (s00 + ai * HALF + m * 16) >> 5, rq = 16 * (m & 1) + fr;
#pragma unroll
                    for (int bj = 0; bj < 2; ++bj) { const f32x4 v0 = acc[ai][bj][m][0] * rr[ai][m], v1 = acc[ai][bj][m][1] * rr[ai][m];
                        u32x4 w; w.x = cvt_pk_bf16(v0[0], v0[1]); w.y = cvt_pk_bf16(v0[2], v0[3]); w.z = cvt_pk_bf16(v1[0], v1[1]); w.w = cvt_pk_bf16(v1[2], v1[3]);
                        *(u32x4*)(base + ((((size_t)((b * 16 + h0 + bj) * 64 + t) * 8 + ks) * 64) + hq * 32 + rq) * 8) = w; } }
        }
    }
};
struct EpiGates {
    static constexpr bool PERM = true, AFTER_DRAIN = false, FP8 = true;
    const ssq_t* ssin; unsigned char* SA8;
    __device__ __forceinline__ void operator()(const f32x4 (&acc)[2][2][4][2], const Unit& u, int wr, int wc, int fr, int fq) const {
        const int colt = u.pn * BM, row0 = u.pm * BM + wr * 64 + fr;
        unsigned char* base = SA8 + ((size_t)(colt >> 12) << 26); const int col0 = (colt & 4095) + wc * 32 + 8 * fq;
#pragma unroll
        for (int ai = 0; ai < 2; ++ai)
#pragma unroll
            for (int m = 0; m < 4; ++m) { const int row = row0 + ai * HALF + m * 16; unsigned char* rowp = base + (size_t)row * 4096 + col0;
                const float rr = F8_UNSCALE / sqrtf(ss_dec(ssin[row]) * (1.0f / 4096.0f) + 1e-6f);
#pragma unroll
                for (int bj = 0; bj < 2; ++bj) { const f32x4 v0 = acc[ai][bj][m][0] * rr, v1 = acc[ai][bj][m][1] * rr;
                    u32x2 w; w.x = pack4q(sigm(v0[0]), sigm(v0[1]), sigm(v0[2]), sigm(v0[3])); w.y = pack4q(sigm(v1[0]), sigm(v1[1]), sigm(v1[2]), sigm(v1[3]));
                    *(u32x2*)(rowp + bj * HALF) = w; } }
    }
};
template <int MODE, bool OT  , bool XT  , bool F8 = false  > struct EpiB {
    static constexpr bool PERM = true, AFTER_DRAIN = false, FP8 = F8;
    bf16_t* O; const bf16_t* X; const bf16_t* Y; int ldc; const ssq_t* ssin;
    __device__ __forceinline__ void operator()(const f32x4 (&acc)[2][2][4][2], const Unit& u, int wr, int wc, int fr, int fq) const {
        const int row0 = u.pm * BM + wr * 64 + fr, col0 = u.pn * BM + wc * 32 + 8 * fq;
#pragma unroll
        for (int ai = 0; ai < 2; ++ai) {
            u32x4 xw[4][2], yw[4][2]; float r2[4];
#pragma unroll
            for (int m = 0; m < 4; ++m) { const size_t off = (size_t)(row0 + ai * HALF + m * 16) * ldc + col0;
                r2[m] = 1.f; if (MODE == 1) r2[m] = ss_dec(ssin[row0 + ai * HALF + m * 16]);
#pragma unroll
                for (int bj = 0; bj < 2; ++bj) {
                    if (MODE == 3) { const u32x2 g8 = *(const u32x2*)((const unsigned char*)X + off + bj * HALF); xw[m][bj] = (u32x4){g8.x, g8.y, 0u, 0u}; }
                    else if (MODE >= 2) xw[m][bj] = *(const u32x4*)(X + (XT ? tix(row0 + ai * HALF + m * 16, col0 + bj * HALF) : off + bj * HALF));
                    if (MODE == 4) { const u32x2 g8 = *(const u32x2*)((const unsigned char*)Y + off + bj * HALF); yw[m][bj] = (u32x4){g8.x, g8.y, 0u, 0u}; } } }
#pragma unroll
            for (int m = 0; m < 4; ++m) { const size_t off = (size_t)(row0 + ai * HALF + m * 16) * ldc + col0;
                if (MODE == 1) r2[m] = 1.0f / (r2[m] * (1.0f / 4096.0f) + 1e-6f);
#pragma unroll
                for (int bj = 0; bj < 2; ++bj) { float v[8];
#pragma unroll
                    for (int j = 0; j < 4; ++j) { v[j] = acc[ai][bj][m][0][j]; v[4 + j] = acc[ai][bj][m][1][j]; }
                    if (MODE == 1) {
#pragma unroll
                        for (int j = 0; j < 8; ++j) { const float t = fmaxf(v[j], 0.f); v[j] = t * t * r2[m]; } }
                    if (MODE >= 2) { const u32x4 xq = xw[m][bj]; float x[8];
                        if (MODE == 3) {
#pragma unroll
                            for (int j = 0; j < 4; ++j) { x[j] = (float)((xq.x >> (8 * j)) & 0xffu) * (1.0f / 255.0f); x[4 + j] = (float)((xq.y >> (8 * j)) & 0xffu) * (1.0f / 255.0f); } }
                        else { x[0] = bf_lo(xq.x); x[1] = bf_hi(xq.x); x[2] = bf_lo(xq.y); x[3] = bf_hi(xq.y); x[4] = bf_lo(xq.z); x[5] = bf_hi(xq.z); x[6] = bf_lo(xq.w); x[7] = bf_hi(xq.w); }
                        if (MODE == 2) {
#pragma unroll
                            for (int j = 0; j < 8; ++j) v[j] = x[j] * sigm(F8 ? v[j] * F8_UNSCALE : v[j]); }
                        if (MODE == 3) {
#pragma unroll
                            for (int j = 0; j < 8; ++j) v[j] = x[j] * v[j]; }
                        if (MODE == 4) { const u32x4 yq = yw[m][bj]; float y[8];
#pragma unroll
                            for (int j = 0; j < 4; ++j) { y[j] = (float)((yq.x >> (8 * j)) & 0xffu) * (1.0f / 255.0f); y[4 + j] = (float)((yq.y >> (8 * j)) & 0xffu) * (1.0f / 255.0f); }
#pragma unroll
                            for (int j = 0; j < 8; ++j) v[j] = x[j] + y[j] * v[j]; } }
                    u32x4 w; w.x = cvt_pk_bf16(v[0], v[1]); w.y = cvt_pk_bf16(v[2], v[3]); w.z = cvt_pk_bf16(v[4], v[5]); w.w = cvt_pk_bf16(v[6], v[7]);
                    *(u32x4*)(O + (OT ? tix(row0 + ai * HALF + m * 16, col0 + bj * HALF) : off + bj * HALF)) = w; } }
            asm volatile("" ::: "memory"); }
    }
};
template <bool GATE, bool H8 = true> struct EpiRes {
    static constexpr bool PERM = true, AFTER_DRAIN = false, FP8 = GATE;
#ifndef EPIRES_NB
#define EPIRES_NB 4
#endif
    static constexpr int NB = GATE ? 1 : EPIRES_NB;
    const bf16_t* base; bf16_t* out; const bf16_t* pe; const ssq_t* ssin; ssq_t* ssout; int nx; unsigned char* h8out;
    __device__ __forceinline__ void operator()(const f32x4 (&acc)[2][2][4][2], const Unit& u, int wr, int wc, int fr, int fq) const {
        const int row0 = u.pm * BM + wr * 64 + fr, col0 = u.pn * BM + wc * 32 + 8 * fq;
        const bool NEXT = nx != 0;
#pragma unroll
        for (int g0 = 0; g0 < 8; g0 += NB) {
            u32x4 bb[NB][2], pp[NB][2]; float rin[NB];
#pragma unroll
            for (int gi = 0; gi < NB; ++gi) { const int ai = (g0 + gi) >> 2, m = (g0 + gi) & 3, row = row0 + ai * HALF + m * 16; const size_t off = (size_t)row * 4096 + col0;
                rin[gi] = 1.f; if (GATE) rin[gi] = ss_dec(ssin[row]);
#pragma unroll
                for (int bj = 0; bj < 2; ++bj) { bb[gi][bj] = *(const u32x4*)(base + tix(row, col0 + bj * HALF)); if (GATE) pp[gi][bj] = *(const u32x4*)(pe + off + bj * HALF); } }
#pragma unroll
            for (int gi = 0; gi < NB; ++gi) { const int ai = (g0 + gi) >> 2, m = (g0 + gi) & 3, row = row0 + ai * HALF + m * 16;
                if (GATE) rin[gi] = F8_UNSCALE / sqrtf(rin[gi] * (1.0f / 4096.0f) + 1e-6f);
                float sq = 0.f;
#pragma unroll
                for (int bj = 0; bj < 2; ++bj) { f32x4 a0 = acc[ai][bj][m][0], a1 = acc[ai][bj][m][1];
                    if (GATE) { const u32x4 pw = pp[gi][bj]; const float rr = rin[gi];
                        a0[0] = bf_lo(pw.x) * sigm(a0[0] * rr); a0[1] = bf_hi(pw.x) * sigm(a0[1] * rr); a0[2] = bf_lo(pw.y) * sigm(a0[2] * rr); a0[3] = bf_hi(pw.y) * sigm(a0[3] * rr);
                        a1[0] = bf_lo(pw.z) * sigm(a1[0] * rr); a1[1] = bf_hi(pw.z) * sigm(a1[1] * rr); a1[2] = bf_lo(pw.w) * sigm(a1[2] * rr); a1[3] = bf_hi(pw.w) * sigm(a1[3] * rr); }
                    const u32x4 bw = bb[gi][bj];
                    const f32x4 h0 = (f32x4){bf_lo(bw.x), bf_hi(bw.x), bf_lo(bw.y), bf_hi(bw.y)} + a0, h1 = (f32x4){bf_lo(bw.z), bf_hi(bw.z), bf_lo(bw.w), bf_hi(bw.w)} + a1;
                    u32x4 hw; hw.x = cvt_pk_bf16(h0[0], h0[1]); hw.y = cvt_pk_bf16(h0[2], h0[3]); hw.z = cvt_pk_bf16(h1[0], h1[1]); hw.w = cvt_pk_bf16(h1[2], h1[3]);
                    *(u32x4*)(out + tix(row, col0 + bj * HALF)) = hw;
                    if (H8 && h8out) { u32x2 q; q.x = pk4_fp8(h0[0] * F8_ASCALE, h0[1] * F8_ASCALE, h0[2] * F8_ASCALE, h0[3] * F8_ASCALE); q.y = pk4_fp8(h1[0] * F8_ASCALE, h1[1] * F8_ASCALE, h1[2] * F8_ASCALE, h1[3] * F8_ASCALE);
                        *(u32x2*)(h8out + tix8(row, col0 + bj * HALF)) = q; }
                    if (NEXT) sq += (h0[0] * h0[0] + h0[1] * h0[1]) + (h0[2] * h0[2] + h0[3] * h0[3]) + (h1[0] * h1[0] + h1[1] * h1[1]) + (h1[2] * h1[2] + h1[3] * h1[3]); }
                if (NEXT) { sq += __shfl_xor(sq, 16); sq += __shfl_xor(sq, 32); if (fq == 0) atomicAdd(ssout + row, ss_enc(sq)); } }
            asm volatile("" ::: "memory"); }
    }
};
template <class Epi, class Sched, bool ALIGN_EPI = false, bool SP2 = false>
__device__ __forceinline__ void gemm_phase(PG8_LAS unsigned char* lds, const Gemm g, const Sched& S, const Epi& E, const int wid_in  ) {
    int lane_ = lane_id(); asm volatile("" : "+v"(lane_));
    const int wid = wid_in, lane = lane_, tid = wid * 64 + lane, wr = wid >> 2, wc = wid & 3, fr = lane & 15, fq = lane >> 4;
    const int K = g.K < 0 ? -g.K : g.K, nt = K / BK;
    unsigned voffA[2], voffB[2];
#pragma unroll
    for (int i = 0; i < 2; ++i) { int R, C; stage_rc(tid * 16 + i * 8192, R, C); const int Rb = Epi::PERM ? ((R & ~31) + perm32(R & 31)) : R;
        voffA[i] = (unsigned)(R * BK + C) * 2u; voffB[i] = (unsigned)(Rb * BK + C) * 2u; }
    const size_t kstepA = (size_t)g.M * BK * 2, kstepB = (size_t)g.N * BK * 2;
    const size_t hstep = (size_t)HALF * BK * 2;
    const size_t tstep = 2 * hstep;
    const unsigned ldsw = (unsigned)wid * 1024u;
    const int aoff = lds_byte(wr * 64 + fr, fq * 8), boff = lds_byte(wc * 32 + fr, fq * 8);
#define PG8_SA(b, h) (((b) * 2 + (h)) * HTB)
#define PG8_SB(b, h) ((4 + (b) * 2 + (h)) * HTB)
#define PG8_STAGE(bufoff, gbase, voff) do { _Pragma("unroll") for (int _i = 0; _i < 2; ++_i) \
        __builtin_amdgcn_global_load_lds((const unsigned*)((const char*)(gbase) + _i * 8192 + (voff)[0]), (PG8_LAS unsigned*)(lds + (bufoff) + ldsw + _i * 8192), 16, 0, 0); } while (0)
#define PG8_LDA(dst, b, h) do { _Pragma("unroll") for (int m = 0; m < 4; ++m) _Pragma("unroll") for (int k = 0; k < 2; ++k) dst[m][k] = *(const PG8_LAS bf16x8*)(lds + PG8_SA(b, h) + aoff + m * 2048 + k * 1024); } while (0)
#define PG8_LDB(dst, b, h) do { _Pragma("unroll") for (int n = 0; n < 2; ++n) _Pragma("unroll") for (int k = 0; k < 2; ++k) dst[n][k] = *(const PG8_LAS bf16x8*)(lds + PG8_SB(b, h) + boff + n * 2048 + k * 1024); } while (0)
#define PG8_CAT(x, y) __builtin_bit_cast(i32x8, __builtin_shufflevector((x), (y), 0, 1, 2, 3, 4, 5, 6, 7, 8, 9, 10, 11, 12, 13, 14, 15))
#define PG8_MMA(ai, bj, At, Bt) do { __builtin_amdgcn_s_setprio(1); \
        if constexpr (Epi::FP8) { _Pragma("unroll") for (int m = 0; m < 4; ++m) _Pragma("unroll") for (int n = 0; n < 2; ++n) \
            asm volatile("v_mfma_f32_16x16x128_f8f6f4 %0, %1, %2, %0" : "+v"(acc[ai][bj][m][n]) : "v"(PG8_CAT(Bt[n][0], Bt[n][1])), "v"(PG8_CAT(At[m][0], At[m][1]))); } \
          \
          \
        else { _Pragma("unroll") for (int m = 0; m < 4; ++m) _Pragma("unroll") for (int n = 0; n < 2; ++n) _Pragma("unroll") for (int k = 0; k < 2; ++k) \
            acc[ai][bj][m][n] = __builtin_amdgcn_mfma_f32_16x16x32_bf16(Bt[n][k], At[m][k], acc[ai][bj][m][n], 0, 0, 0); } \
        __builtin_amdgcn_s_setprio(0); } while (0)
#define PG8_WAIT_V(n) asm volatile("s_waitcnt vmcnt(" #n ")" ::: "memory")
#define PG8_WAIT_L(n) asm volatile("s_waitcnt lgkmcnt(" #n ")" ::: "memory")
#define PG8_BAR __builtin_amdgcn_s_barrier()
#define PG8_SCHED __builtin_amdgcn_sched_barrier(0)
    Unit cur, nxt; int ui = 0;
    if (!S.next(0, cur)) return;
    f32x4 acc[2][2][4][2];
#pragma unroll
    for (int a = 0; a < 2; ++a)
#pragma unroll
        for (int b = 0; b < 2; ++b)
#pragma unroll
            for (int m = 0; m < 4; ++m)
#pragma unroll
                for (int n = 0; n < 2; ++n) acc[a][b][m][n] = (f32x4){0.f, 0.f, 0.f, 0.f};
    bf16x8 At[4][2], B0[2][2], B1[2][2];
    const size_t tstepA = (g.K < 0) ? 0 : tstep, tstepB = tstepA;
    const char* cA = (const char*)g.A + (size_t)cur.pm * tstepA; const char* cB = (const char*)g.Bt + (size_t)cur.pn * tstepB;
    S.a_ready(cur);
    if constexpr (SP2) {
        PG8_STAGE(PG8_SB(0, 0), cB, voffB); PG8_STAGE(PG8_SB(0, 1), cB + hstep, voffB); PG8_STAGE(PG8_SA(0, 0), cA, voffA); PG8_STAGE(PG8_SA(0, 1), cA + hstep, voffA);
        if (wr == 1) PG8_BAR;
        PG8_WAIT_V(2); PG8_BAR;
        PG8_STAGE(PG8_SB(1, 0), cB + kstepB, voffB); PG8_STAGE(PG8_SA(1, 0), cA + kstepA, voffA); PG8_STAGE(PG8_SB(1, 1), cB + hstep + kstepB, voffB);
        PG8_WAIT_V(6); PG8_BAR;
    } else {
        PG8_STAGE(PG8_SB(0, 0), cB, voffB); PG8_STAGE(PG8_SA(0, 0), cA, voffA); PG8_STAGE(PG8_SB(0, 1), cB + hstep, voffB); PG8_STAGE(PG8_SA(0, 1), cA + hstep, voffA);
        if (wr == 1) PG8_BAR;
        PG8_WAIT_V(4); PG8_BAR;
        PG8_STAGE(PG8_SB(1, 0), cB + kstepB, voffB); PG8_STAGE(PG8_SA(1, 0), cA + kstepA, voffA); PG8_STAGE(PG8_SB(1, 1), cB + hstep + kstepB, voffB);
        PG8_WAIT_V(6); PG8_BAR;
    }
    for (;;) {
        const bool has_next = S.next(ui + 1, nxt);
        const char* nA = has_next ? (const char*)g.A + (size_t)nxt.pm * tstepA : cA; const char* nB = has_next ? (const char*)g.Bt + (size_t)nxt.pn * tstepB : cB;
#pragma unroll 1
        for (int t = 0; t < nt; t += 2) {
            const bool last = (t == nt - 2);
            const char* a1 = cA + (size_t)(t + 1) * kstepA;
            const char* a2 = last ? nA : cA + (size_t)(t + 2) * kstepA; const char* b2 = last ? nB : cB + (size_t)(t + 2) * kstepB;
            const char* a3 = a2 + kstepA; const char* b3 = b2 + kstepB;
            if (last && has_next) S.a_ready(nxt);
            if constexpr (SP2) {
            PG8_LDB(B0, 0, 0); PG8_LDB(B1, 0, 1); PG8_SCHED; PG8_LDA(At, 0, 0); PG8_STAGE(PG8_SA(1, 1), a1 + hstep, voffA);
            PG8_WAIT_V(8); PG8_WAIT_L(0); PG8_BAR; PG8_MMA(0, 0, At, B0); PG8_MMA(0, 1, At, B1); PG8_BAR; PG8_SCHED;
            PG8_LDA(At, 0, 1); PG8_STAGE(PG8_SB(0, 0), b2, voffB); PG8_STAGE(PG8_SB(0, 1), b2 + hstep, voffB); PG8_STAGE(PG8_SA(0, 0), a2, voffA);
            PG8_WAIT_V(8); PG8_WAIT_L(0); PG8_BAR; PG8_MMA(1, 0, At, B0); PG8_MMA(1, 1, At, B1); PG8_BAR; PG8_SCHED;
            PG8_LDB(B0, 1, 0); PG8_LDB(B1, 1, 1); PG8_SCHED; PG8_LDA(At, 1, 0); PG8_STAGE(PG8_SA(0, 1), a2 + hstep, voffA);
            PG8_WAIT_V(8); PG8_WAIT_L(0); PG8_BAR; PG8_MMA(0, 0, At, B0); PG8_MMA(0, 1, At, B1); PG8_BAR; PG8_SCHED;
            PG8_LDA(At, 1, 1); PG8_STAGE(PG8_SB(1, 0), b3, voffB); PG8_STAGE(PG8_SB(1, 1), b3 + hstep, voffB); PG8_STAGE(PG8_SA(1, 0), a3, voffA);
            PG8_WAIT_V(8); PG8_WAIT_L(0); PG8_BAR; PG8_MMA(1, 0, At, B0); PG8_MMA(1, 1, At, B1); PG8_BAR; PG8_SCHED;
            } else {
            PG8_LDB(B0, 0, 0); PG8_SCHED; PG8_LDA(At, 0, 0); PG8_STAGE(PG8_SA(1, 1), a1 + hstep, voffA);
            PG8_WAIT_L(8); PG8_BAR; PG8_WAIT_L(0); PG8_MMA(0, 0, At, B0); PG8_BAR; PG8_SCHED;
            PG8_LDB(B1, 0, 1); PG8_STAGE(PG8_SB(0, 0), b2, voffB);
            PG8_BAR; PG8_WAIT_L(0); PG8_MMA(0, 1, At, B1); PG8_BAR;
            PG8_LDA(At, 0, 1); PG8_STAGE(PG8_SA(0, 0), a2, voffA);
            PG8_BAR; PG8_WAIT_L(0); PG8_MMA(1, 0, At, B0); PG8_BAR; PG8_SCHED;
            PG8_STAGE(PG8_SB(0, 1), b2 + hstep, voffB);
            PG8_WAIT_V(6); PG8_BAR; PG8_MMA(1, 1, At, B1); PG8_BAR;
            PG8_LDB(B0, 1, 0); PG8_SCHED; PG8_LDA(At, 1, 0); PG8_STAGE(PG8_SA(0, 1), a2 + hstep, voffA);
            PG8_WAIT_L(8); PG8_BAR; PG8_WAIT_L(0); PG8_MMA(0, 0, At, B0); PG8_BAR; PG8_SCHED;
            PG8_LDB(B1, 1, 1); PG8_STAGE(PG8_SB(1, 0), b3, voffB);
            PG8_BAR; PG8_WAIT_L(0); PG8_MMA(0, 1, At, B1); PG8_BAR;
            PG8_LDA(At, 1, 1); PG8_STAGE(PG8_SA(1, 0), a3, voffA);
            PG8_BAR; PG8_WAIT_L(0); PG8_MMA(1, 0, At, B0); PG8_BAR; PG8_SCHED;
            PG8_STAGE(PG8_SB(1, 1), b3 + hstep, voffB);
            PG8_WAIT_V(6); PG8_BAR; PG8_MMA(1, 1, At, B1); PG8_BAR;
            }
        }
        if constexpr (ALIGN_EPI) { if (wr == 0) PG8_BAR; }
        if constexpr (Epi::FP8) asm volatile("s_nop 15\n\ts_nop 15" ::: "memory");
        if constexpr (!Epi::AFTER_DRAIN) { int l2 = lane_id(); asm volatile("" : "+v"(l2)); E(acc, cur, wr, wc, l2 & 15, l2 >> 4); S.done(cur); }
        if (!has_next) break;
#pragma unroll
        for (int a = 0; a < 2; ++a)
#pragma unroll
            for (int b = 0; b < 2; ++b)
#pragma unroll
                for (int m = 0; m < 4; ++m)
#pragma unroll
                    for (int n = 0; n < 2; ++n) acc[a][b][m][n] = (f32x4){0.f, 0.f, 0.f, 0.f};
        cur = nxt; cA = nA; cB = nB; ++ui;
        if constexpr (ALIGN_EPI) { if (wr == 1) PG8_BAR; }
    }
    PG8_WAIT_V(0);
    if constexpr (!ALIGN_EPI) { if (wr == 0) PG8_BAR; }
    PG8_BAR;
    if constexpr (Epi::AFTER_DRAIN) { E.fused(acc, cur, wr, wc, fr, fq, lds, wid, lane); S.done(cur); }
#undef PG8_SA
#undef PG8_SB
#undef PG8_STAGE
#undef PG8_LDA
#undef PG8_LDB
#undef PG8_MMA
#undef PG8_CAT
#undef PG8_WAIT_V
#undef PG8_WAIT_L
#undef PG8_BAR
#undef PG8_SCHED
}
}
constexpr int NWAVES = 8;
constexpr int BATCH = 4, SEQ = 2048, DM = 4096, DEPTH = 2, AW = 2048, NH = 16, HD = 128, SW = 2048, NG = 128, NP = 64, NC = 16, DFF = 16384, PLE = 256, INW = 16384;
constexpr int M = BATCH * SEQ;
constexpr float RMS_EPS = 1e-6f;
#ifndef MK_N_LAUNCHES
#define MK_N_LAUNCHES 1
#endif
constexpr int PH_PER_LAYER = 8, N_PHASES = 2 + DEPTH * PH_PER_LAYER + 1;

constexpr size_t MiB = 1u << 20;
constexpr size_t WS_CTL = 0, CTL_ZERO_BYTES = 1 * MiB;
constexpr size_t WS_W = 1 * MiB, W_LAYER = 490 * MiB;
constexpr size_t WO_IN = 0, WO_BRA = 128 * MiB, WO_GLU = 144 * MiB, WO_BRS = 152 * MiB, WO_O = 168 * MiB, WO_FF1 = 200 * MiB, WO_FF2 = 328 * MiB, WO_PG = 456 * MiB, WO_PLE = 488 * MiB;
constexpr size_t WS_SSM = WS_W + 2 * W_LAYER, SSM_LAYER = 33 * MiB;
constexpr size_t SO_T = 0, SO_E = 16 * MiB, SO_F = 24 * MiB, SO_L16 = 32 * MiB;
constexpr size_t WS_H = WS_SSM + 2 * SSM_LAYER;
constexpr size_t WS_PB = WS_H + 128 * MiB;
constexpr size_t WS_PE = WS_PB + 8 * MiB;
constexpr size_t WS_ACT = WS_PE + 128 * MiB;
constexpr size_t AO_Q = 0, AO_K = 32 * MiB, AO_VP = 64 * MiB, AO_U = 96 * MiB, AO_ATT = 128 * MiB, AO_Y = 160 * MiB, AO_SSM = 192 * MiB, AO_SA = 224 * MiB, AO_SS = 288 * MiB, AO_TMP = 352 * MiB, AO_MRG = 416 * MiB;
static_assert(AO_Q == 0 && AO_K == 32 * MiB && AO_VP == 64 * MiB && AO_U == 96 * MiB && AO_SA == 224 * MiB && AO_SS == 288 * MiB, "EpiIn's pointer arithmetic");
constexpr size_t WS_MID = WS_ACT;
constexpr size_t WS_H8 = WS_ACT + 480 * MiB;
constexpr size_t WS_Y8 = WS_H8 + 64 * MiB;
constexpr size_t WS_END = WS_Y8 + 16 * MiB;
constexpr size_t CTL_SS = 256 * 1024;
constexpr int CW_BAR = 4096;

constexpr int LDS_BYTES = 155648;
constexpr int MISC_OFF = LDS_BYTES - 256;

#define GAS __attribute__((address_space(1)))
#define LAS __attribute__((address_space(3)))
typedef unsigned short bf16;
typedef unsigned v4u __attribute__((ext_vector_type(4)));
typedef unsigned v2u __attribute__((ext_vector_type(2)));
typedef float f32x4 __attribute__((ext_vector_type(4)));
typedef float f32x2 __attribute__((ext_vector_type(2)));
typedef float f32x16 __attribute__((ext_vector_type(16)));
typedef short bf16x8 __attribute__((ext_vector_type(8)));
typedef __bf16 bf16x2v __attribute__((ext_vector_type(2)));
typedef GAS unsigned gu32;
#define RLX_AGENT __ATOMIC_RELAXED, __HIP_MEMORY_SCOPE_AGENT
#define LDS_WAIT() asm volatile("s_waitcnt lgkmcnt(0)" ::: "memory")
#define VM_WAIT() asm volatile("s_waitcnt vmcnt(0)" ::: "memory")
#define MFMA32(a, b, c) __builtin_amdgcn_mfma_f32_32x32x16_bf16((a), (b), (c), 0, 0, 0)
__device__ __forceinline__ unsigned pk2(float lo, float hi) { const f32x2 v = {lo, hi}; return __builtin_bit_cast(unsigned, __builtin_convertvector(v, bf16x2v)); }
__device__ __forceinline__ float bflo(unsigned w) { return __uint_as_float(w << 16); }
__device__ __forceinline__ float bfhi(unsigned w) { return __uint_as_float(w & 0xffff0000u); }
__device__ __forceinline__ int crow(int i, int h) { return (i & 3) + 8 * (i >> 2) + 4 * h; }
#define XB_TMO      128
#define XB_XCNT(j)  (256  + 64 * (j))
#define XB_XSUB(j)  (1280 + 64 * (j))
#define XB_XGEN(j)  (2304 + 64 * (j))
#define XB_TOP      3328
#define XB_TOPGEN   3392
#define XCD_BAR_WORDS 3456
#define XB_SPIN_CAP (1u << 18)

__device__ __forceinline__ unsigned xb_ld(unsigned* p)              { return __hip_atomic_load(p, __ATOMIC_RELAXED, __HIP_MEMORY_SCOPE_AGENT); }
__device__ __forceinline__ unsigned xb_add(unsigned* p, unsigned v) { return __hip_atomic_fetch_add(p, v, __ATOMIC_RELAXED, __HIP_MEMORY_SCOPE_AGENT); }
__device__ __forceinline__ unsigned xb_xcc_id() { return (unsigned)__builtin_amdgcn_s_getreg((3 << 11) | 20) & 0xFu; }
#define XB_SPIN(cond, bar) do { unsigned _sp = 0; while (cond) { __builtin_amdgcn_s_sleep(1); \
    if ((++_sp & 255u) == 0u) { if (xb_ld(&(bar)[XB_TMO])) break; if (_sp > XB_SPIN_CAP) { atomicAdd(&(bar)[XB_TMO], 1u); break; } } } } while (0)

struct XcdBarrier {
    unsigned* bar; unsigned x; bool t0;
    volatile LAS unsigned* st;
};

__device__ __forceinline__ XcdBarrier xcd_barrier_post(unsigned* bar, volatile LAS unsigned* st) {
    XcdBarrier b; b.bar = bar; b.x = xb_xcc_id(); b.st = st; b.t0 = (threadIdx.x == 0);
    if (threadIdx.x == 0) (void)xb_add(&bar[XB_XCNT(b.x)], 1u);
    return b;
}
__device__ __forceinline__ void xcd_barrier_complete(unsigned* bar, unsigned x, unsigned& nloc, unsigned& nx) {
    const unsigned G = gridDim.x * gridDim.y * gridDim.z;
    unsigned sum, cnt, mine, sp = 0u;
    for (;;) {
        sum = 0u; cnt = 0u; mine = 0u;
#pragma unroll
        for (unsigned j = 0; j < 16; ++j) { const unsigned c = xb_ld(&bar[XB_XCNT(j)]); sum += c; cnt += (c > 0u) ? 1u : 0u; mine = (j == x) ? c : mine; }
        if (sum == G) break;
        __builtin_amdgcn_s_sleep(1);
        if ((++sp & 255u) == 0u) { if (xb_ld(&bar[XB_TMO])) break; if (sp > XB_SPIN_CAP) { atomicAdd(&bar[XB_TMO], 1u); break; } }
    }
    nloc = mine > 0u ? mine : 1u; nx = cnt > 0u ? cnt : 1u;
}

__device__ __forceinline__ void xcd_barrier(const XcdBarrier& b) {
    asm volatile("s_waitcnt vmcnt(0)" ::: "memory");
    __syncthreads();
    if (b.t0) {
        unsigned* bar = b.bar;
        __builtin_amdgcn_s_waitcnt(0);
        unsigned nloc = b.st[0], nx = b.st[1];
        if (nloc == 0u) { xcd_barrier_complete(bar, b.x, nloc, nx); b.st[0] = nloc; b.st[1] = nx; }
        const unsigned old = xb_add(&bar[XB_XSUB(b.x)], 1u);
        const unsigned gen = old / nloc;
        if (old + 1u == (gen + 1u) * nloc) {
            __builtin_amdgcn_fence(__ATOMIC_RELEASE, "agent");
            asm volatile("s_waitcnt vmcnt(0)" ::: "memory");
            const unsigned og = xb_add(&bar[XB_TOP], 1u);
            const unsigned tg = og / nx;
            if (og + 1u == (tg + 1u) * nx) xb_add(&bar[XB_TOPGEN], 1u);
            else XB_SPIN(xb_ld(&bar[XB_TOPGEN]) == tg, bar);
            __builtin_amdgcn_fence(__ATOMIC_ACQUIRE, "agent");
            xb_add(&bar[XB_XGEN(b.x)], 1u);
            asm volatile("s_waitcnt vmcnt(0)" ::: "memory");
        } else {
            XB_SPIN(xb_ld(&bar[XB_XGEN(b.x)]) == gen, bar);
            __builtin_amdgcn_fence(__ATOMIC_ACQUIRE, "agent");
            asm volatile("s_waitcnt vmcnt(0)" ::: "memory");
        }
    }
    __syncthreads();
}

struct Args { const float* in[23]; float* out; unsigned char* ws; int ph_lo, ph_hi, li, pad; };
typedef __attribute__((address_space(4))) const Args* KArgP0;
enum { I_X = 0, I_P, I_GMIX, I_WIN, I_WBRA, I_LRE, I_LIM, I_LOGDT, I_BRE, I_BIM, I_CRE, I_CIM, I_DSKIP, I_WGLU, I_WBRS, I_WO, I_GMLP, I_WFF1, I_WFF2, I_GPLE, I_WPG, I_WPLE, I_GFIN };

__device__ __forceinline__ float wave_sum(float v) {
#pragma unroll
    for (int o = 1; o < 64; o <<= 1) v += __shfl_xor(v, o);
    return v;
}
struct TrDesc { const float* src; bf16* dst; const float* gk; int K; size_t N; int f8; };
constexpr int TR_IN = 16384, TR_BRA = 2048, TR_GLU = 1024, TR_BRS = 2048, TR_O = 4096, TR_FF1 = 16384, TR_FF2 = 16384, TR_PG = 4096, TR_PLE = 256;
constexpr int TR_LAYER = TR_IN + TR_BRA + TR_GLU + TR_BRS + TR_O + TR_FF1 + TR_FF2 + TR_PG + TR_PLE;
__device__ __forceinline__ TrDesc tr_desc(KArgP0 a, int it, int lane) {
    const int L = it / TR_LAYER; int r = it - L * TR_LAYER;
    unsigned char* wl = a->ws + WS_W + (size_t)L * W_LAYER;
    const float* W; int K, N; size_t wo; const float* gv = nullptr; int f8 = 0;
    int win = 0;
    if (r < TR_IN) { W = a->in[I_WIN] + (size_t)L * DM * INW; K = DM; N = INW; wo = WO_IN; gv = a->in[I_GMIX] + L * DM; win = 1; }
    else if ((r -= TR_IN) < TR_BRA) { W = a->in[I_WBRA] + (size_t)L * AW * DM; K = AW; N = DM; wo = WO_BRA; }
    else if ((r -= TR_BRA) < TR_GLU) { W = a->in[I_WGLU] + (size_t)L * SW * SW; K = SW; N = SW; wo = WO_GLU; f8 = 1; }
    else if ((r -= TR_GLU) < TR_BRS) { W = a->in[I_WBRS] + (size_t)L * SW * DM; K = SW; N = DM; wo = WO_BRS; }
    else if ((r -= TR_BRS) < TR_O) { W = a->in[I_WO] + (size_t)L * DM * DM; K = DM; N = DM; wo = WO_O; }
    else if ((r -= TR_O) < TR_FF1) { W = a->in[I_WFF1] + (size_t)L * DM * DFF; K = DM; N = DFF; wo = WO_FF1; gv = a->in[I_GMLP] + L * DM; }
    else if ((r -= TR_FF1) < TR_FF2) { W = a->in[I_WFF2] + (size_t)L * DFF * DM; K = DFF; N = DM; wo = WO_FF2; }
    else if ((r -= TR_FF2) < TR_PG) { W = a->in[I_WPG] + (size_t)L * DM * DM; K = DM; N = DM; wo = WO_PG; gv = a->in[I_GPLE] + L * DM; f8 = 1; }
    else { r -= TR_PG; W = a->in[I_WPLE] + (size_t)L * PLE * DM; K = PLE; N = DM; wo = WO_PLE; }
    const int nblk = N >> 6, kb = r / nblk, nb = r - kb * nblk, k0 = kb * 64, n0 = nb * 64;
    TrDesc t; t.src = W + (size_t)(k0 + (lane >> 4)) * N + n0 + 4 * (lane & 15); t.dst = (bf16*)(wl + wo) + ((size_t)kb * N + n0 + (lane >> 3)) * 64 + 8 * (lane & 7); t.K = 64; t.N = (size_t)N; t.gk = gv ? gv + k0 + 8 * (lane & 7) : nullptr; t.f8 = f8;
    if (f8) t.dst = (bf16*)((unsigned char*)(wl + wo) + ((size_t)(k0 >> 7) * N + n0 + (lane >> 3)) * 128 + (k0 & 127) + 8 * (lane & 7));
    if (win) {
        if (n0 < 8192) t.dst = (bf16*)(wl + wo) + ((size_t)kb * 8192 + n0 + (lane >> 3)) * 64 + 8 * (lane & 7);
        else { t.f8 = 1; t.dst = (bf16*)((unsigned char*)(wl + wo) + (64u << 20) + ((size_t)(k0 >> 7) * 8192 + (n0 - 8192) + (lane >> 3)) * 128 + (k0 & 127) + 8 * (lane & 7)); } }
    return t;
}
__device__ __forceinline__ void tr_load(f32x4 (&v)[16], const TrDesc& t) {
#pragma unroll
    for (int i = 0; i < 16; ++i) v[i] = __builtin_nontemporal_load((const f32x4*)(t.src + (size_t)(4 * i) * t.N));
}
__device__ __forceinline__ void tr_store(const f32x4 (&v)[16], const TrDesc& t, LAS float* scr, int lane) {
    LAS float* d = scr + (lane >> 4) * 65 + 4 * (lane & 15);
#pragma unroll
    for (int i = 0; i < 16; ++i) { LAS float* dd = d + (4 * i) * 65; dd[0] = v[i].x; dd[1] = v[i].y; dd[2] = v[i].z; dd[3] = v[i].w; }
    LDS_WAIT(); asm volatile("" ::: "memory");
    const LAS float* s0 = scr + (8 * (lane & 7)) * 65 + (lane >> 3);
    f32x4 g0 = {1.f, 1.f, 1.f, 1.f}, g1 = g0; if (t.gk) { g0 = *(const f32x4*)t.gk; g1 = *(const f32x4*)(t.gk + 4); }
    if (t.f8) { g0 = g0 * pg8::F8_WSCALE; g1 = g1 * pg8::F8_WSCALE; }
#pragma unroll
    for (int jj = 0; jj < 8; ++jj) { const LAS float* s = s0 + 8 * jj;
        if (t.f8) { v2u q; q.x = pg8::pk4_fp8(s[0] * g0.x, s[65] * g0.y, s[2 * 65] * g0.z, s[3 * 65] * g0.w); q.y = pg8::pk4_fp8(s[4 * 65] * g1.x, s[5 * 65] * g1.y, s[6 * 65] * g1.z, s[7 * 65] * g1.w);
            __builtin_nontemporal_store(q, (v2u*)(t.dst + (size_t)(8 * jj) * t.K)); continue; }
        v4u o; o.x = pk2(s[0] * g0.x, s[65] * g0.y); o.y = pk2(s[2 * 65] * g0.z, s[3 * 65] * g0.w); o.z = pk2(s[4 * 65] * g1.x, s[5 * 65] * g1.y); o.w = pk2(s[6 * 65] * g1.z, s[7 * 65] * g1.w);
        __builtin_nontemporal_store(o, (v4u*)(t.dst + (size_t)(8 * jj) * t.K)); }
    LDS_WAIT(); asm volatile("" ::: "memory");
}
__device__ __forceinline__ void tr_all(KArgP0 a, int gw, int NGW, LAS float* scr, int lane) {
    constexpr int NIT = DEPTH * TR_LAYER;
    int it = gw; if (it >= NIT) return;
    f32x4 va[16], vb[16];
    TrDesc ta = tr_desc(a, it, lane), tb = ta; tr_load(va, ta);
    for (;;) {
        const bool hb = (it + NGW < NIT); if (hb) { tb = tr_desc(a, it + NGW, lane); tr_load(vb, tb); }
        tr_store(va, ta, scr, lane); if (!hb) break; it += NGW;
        const bool ha = (it + NGW < NIT); if (ha) { ta = tr_desc(a, it + NGW, lane); tr_load(va, ta); }
        tr_store(vb, tb, scr, lane); if (!ha) break; it += NGW;
    }
}
struct QkvuOrder : pg8::StaticOrder {
    __device__ __forceinline__ bool next(int i, pg8::Unit& u) const {
        if (!pg8::StaticOrder::next(i, u)) return false;
        if (G == 256 && nN == 32 && (i & 1)) u.pn ^= 16;
        return true;
    }
};
__device__ __forceinline__ void ssm_prep(KArgP0 a, int L, int g, LAS unsigned char* lds, int tid) {
    LAS float* lamp = (LAS float*)lds;
    LAS float* bbar = lamp + 64 * 17 * 2;
    LAS float* ccv = bbar + 64 * 16 * 2;
    LAS float* Kd = ccv + 16 * 64 * 2;
    const int lg = L * NG + g;
    const float* lre = a->in[I_LRE] + lg * NP; const float* lim = a->in[I_LIM] + lg * NP;
    const float* bre = a->in[I_BRE] + (size_t)lg * NP * NC; const float* bim = a->in[I_BIM] + (size_t)lg * NP * NC;
    const float* cre = a->in[I_CRE] + (size_t)lg * NC * NP; const float* cim = a->in[I_CIM] + (size_t)lg * NC * NP;
    const float dt = expf(a->in[I_LOGDT][lg]);
    for (int t = tid; t < 64 * 17; t += 512) { const int p = t / 17, d = t - 17 * p; const float ar = lre[p] * dt * (float)d, th = lim[p] * dt * (float)d, e = expf(ar);
        lamp[2 * t] = e * cosf(th); lamp[2 * t + 1] = e * sinf(th); }
    for (int t = tid; t < 64 * 16; t += 512) { const int p = t >> 4; const float lr = lre[p], li = lim[p], ar = lr * dt, th = li * dt;
        const float ea = expf(ar), em1 = expm1f(ar), sn = sinf(th), cs = cosf(th), sh = sinf(0.5f * th);
        const float nr = em1 * cs - 2.f * sh * sh, ni = ea * sn, den = lr * lr + li * li;
        const float cr = (nr * lr + ni * li) / den, ci = (ni * lr - nr * li) / den;
        const float br = bre[t], bi = bim[t];
        bbar[2 * t] = cr * br - ci * bi; bbar[2 * t + 1] = cr * bi + ci * br;
        ccv[2 * t] = cre[t]; ccv[2 * t + 1] = cim[t]; }
    __syncthreads();
    for (int t = tid; t < 4096; t += 512) { const int d = t >> 8, c = (t >> 4) & 15, c2 = t & 15; float acc = 0.f;
        for (int p = 0; p < 64; ++p) { const float cr = ccv[2 * (c * 64 + p)], ci = ccv[2 * (c * 64 + p) + 1], lr = lamp[2 * (p * 17 + d)], li = lamp[2 * (p * 17 + d) + 1];
            const float br = bbar[2 * (p * 16 + c2)], bi = bbar[2 * (p * 16 + c2) + 1], xr = cr * lr - ci * li, xi = cr * li + ci * lr; acc += xr * br - xi * bi; }
        Kd[t] = acc; }
    __syncthreads();
    unsigned char* sl = a->ws + WS_SSM + (size_t)L * SSM_LAYER;
    bf16* Tg = (bf16*)(sl + SO_T) + (size_t)g * 256 * 256; bf16* Eg = (bf16*)(sl + SO_E) + (size_t)g * 128 * 256; bf16* Fg = (bf16*)(sl + SO_F) + (size_t)g * 256 * 128;
    for (int ch = tid; ch < 8192; ch += 512) { const int n = ch >> 5, kc = ch & 31, i = n >> 4, c = n & 15, j = kc >> 1, c20 = (kc & 1) * 8; float v[8];
#pragma unroll
        for (int e = 0; e < 8; ++e) v[e] = (j <= i) ? Kd[((i - j) * 16 + c) * 16 + c20 + e] : 0.f;
        v4u o; o.x = pk2(v[0], v[1]); o.y = pk2(v[2], v[3]); o.z = pk2(v[4], v[5]); o.w = pk2(v[6], v[7]); *(v4u*)(Tg + ((size_t)(((n >> 5) * 16 + (kc >> 1)) * 64) + (kc & 1) * 32 + (n & 31)) * 8) = o; }
    for (int ch = tid; ch < 4096; ch += 512) { const int n = ch >> 5, kc = ch & 31, p = n >> 1, ri = n & 1, j = kc >> 1, c20 = (kc & 1) * 8; float v[8];
        const float lr = lamp[2 * (p * 17 + 15 - j)], li = lamp[2 * (p * 17 + 15 - j) + 1];
#pragma unroll
        for (int e = 0; e < 8; ++e) { const float br = bbar[2 * (p * 16 + c20 + e)], bi = bbar[2 * (p * 16 + c20 + e) + 1]; v[e] = ri ? (lr * bi + li * br) : (lr * br - li * bi); }
        v4u o; o.x = pk2(v[0], v[1]); o.y = pk2(v[2], v[3]); o.z = pk2(v[4], v[5]); o.w = pk2(v[6], v[7]); *(v4u*)(Eg + ((size_t)(((n >> 5) * 16 + (kc >> 1)) * 64) + (kc & 1) * 32 + (n & 31)) * 8) = o; }
    for (int ch = tid; ch < 4096; ch += 512) { const int n = ch >> 4, kc = ch & 15, i = n >> 4, c = n & 15; float v[8];
#pragma unroll
        for (int e = 0; e < 8; ++e) { const int kk = 8 * kc + e, p = kk >> 1; const float cr = ccv[2 * (c * 64 + p)], ci = ccv[2 * (c * 64 + p) + 1], lr = lamp[2 * (p * 17 + i + 1)], li = lamp[2 * (p * 17 + i + 1) + 1];
            v[e] = (kk & 1) ? -(cr * li + ci * lr) : (cr * lr - ci * li); }
        v4u o; o.x = pk2(v[0], v[1]); o.y = pk2(v[2], v[3]); o.z = pk2(v[4], v[5]); o.w = pk2(v[6], v[7]); *(v4u*)(Fg + ((size_t)(((n >> 5) * 8 + (kc >> 1)) * 64) + (kc & 1) * 32 + (n & 31)) * 8) = o; }
    if (tid < 64) { float* l16 = (float*)(sl + SO_L16) + (size_t)(g * 64 + tid) * 2; l16[0] = lamp[2 * (tid * 17 + 16)]; l16[1] = lamp[2 * (tid * 17 + 16) + 1]; }
    __syncthreads();
}
__device__ __forceinline__ void rms_row_f32(const bf16* H, int m, const float* g, float* orow, int lane) {
    f32x4 v[16]; float s = 0.f;
#pragma unroll
    for (int j = 0; j < 16; ++j) { const v2u w = *(const v2u*)(H + ((size_t)(4 * j + (lane >> 4)) * M + m) * 64 + 4 * (lane & 15)); v[j] = (f32x4){bflo(w.x), bfhi(w.x), bflo(w.y), bfhi(w.y)}; s += (v[j].x * v[j].x + v[j].y * v[j].y) + (v[j].z * v[j].z + v[j].w * v[j].w); }
    const float rs = 1.0f / sqrtf(wave_sum(s) * (1.0f / DM) + RMS_EPS);
    const f32x4* gr = (const f32x4*)g + lane;
#pragma unroll
    for (int j = 0; j < 16; ++j) { const f32x4 gg = gr[64 * j]; ((f32x4*)orow + lane)[64 * j] = v[j] * rs * gg; }
}
__device__ __forceinline__ void prenorm_row(const float* xrow, bf16* H, unsigned char* H8, int m, pg8::ssq_t* ss, int lane) {
    const f32x4* xr = (const f32x4*)xrow + lane; float s = 0.f;
#pragma unroll
    for (int j = 0; j < 16; ++j) { const f32x4 v = xr[64 * j]; s += (v.x * v.x + v.y * v.y) + (v.z * v.z + v.w * v.w);
        v2u hw; hw.x = pk2(v.x, v.y); hw.y = pk2(v.z, v.w); *(v2u*)(H + ((size_t)(4 * j + (lane >> 4)) * M + m) * 64 + 4 * (lane & 15)) = hw;
        *(unsigned*)(H8 + pg8::tix8(m, 4 * lane + 256 * j)) = pg8::pk4_fp8(v.x * pg8::F8_ASCALE, v.y * pg8::F8_ASCALE, v.z * pg8::F8_ASCALE, v.w * pg8::F8_ASCALE); }
    s = wave_sum(s); if (lane == 0) *ss = pg8::ss_enc(s);
}
__device__ __forceinline__ void swap_halves(unsigned& a, unsigned& b) { const auto r = __builtin_amdgcn_permlane32_swap(a, b, false, false); a = r[0]; b = r[1]; }
__device__ __forceinline__ float gelu_tanh(float x) { const float u = 0.7978845608028654f * (x + 0.044715f * x * x * x); const float t = 1.0f - 2.0f / (__expf(2.0f * u) + 1.0f); return 0.5f * x * (1.0f + t); }
__device__ __forceinline__ void attn_wave(const bf16* Q, const bf16* Kb, const bf16* VP, bf16* O, int b, int h, int q0, int lane) {
    const int r = lane & 31, hh = lane >> 5;
    const float scale = 0.08838834764831845f;
    const size_t bh = (size_t)(b * NH + h);
    const bf16* qfp = Q + ((bh * 64 + (q0 >> 5)) * 8 * 64 + lane) * 8;
    bf16x8 qf[8];
#pragma unroll
    for (int ks = 0; ks < 8; ++ks) qf[ks] = *(const bf16x8*)(qfp + ks * 512);
    f32x16 o[4];
#pragma unroll
    for (int d = 0; d < 4; ++d)
#pragma unroll
        for (int i = 0; i < 16; ++i) o[d][i] = 0.f;
    float R = 1.f;
    const bf16* kbase = Kb + (bh * 64 * 8 * 64 + lane) * 8;
    const bf16* vbase = VP + (bh * 64 * 8 * 64 + lane) * 8;
    const int ktd = q0 >> 5;
    bf16x8 kf[8];
    { const bf16* kp = kbase + (size_t)ktd * 4096;
#pragma unroll
      for (int ks = 0; ks < 8; ++ks) kf[ks] = *(const bf16x8*)(kp + ks * 512); }
#pragma unroll 1
    for (int kt = ktd; kt >= 0; --kt) {
        f32x16 s;
#pragma unroll
        for (int i = 0; i < 16; ++i) s[i] = 0.f;
#pragma unroll
        for (int ks = 0; ks < 8; ++ks) s = MFMA32(kf[ks], qf[ks], s);
        { const bf16* kp = kbase + (size_t)(kt > 0 ? kt - 1 : 0) * 4096;
#pragma unroll
          for (int ks = 0; ks < 8; ++ks) kf[ks] = *(const bf16x8*)(kp + ks * 512); }
        bf16x8 vf[2][4];
#pragma unroll
        for (int sx = 0; sx < 2; ++sx)
#pragma unroll
            for (int db = 0; db < 4; ++db) vf[sx][db] = *(const bf16x8*)(vbase + (size_t)((kt * 4 + db) * 2 + sx) * 512);
        const bool diag = (kt == ktd);
        float be[16], om[16];
#pragma unroll
        for (int i = 0; i < 16; ++i) { const float z = s[i], a = __builtin_amdgcn_exp2f(-fabsf(z) * (scale * 1.4426950408889634f)), t = __builtin_amdgcn_rcpf(1.0f + a), u = a * t;
            const bool valid = !diag || (crow(i, hh) < r); const bool pos = z >= 0.f;
            be[i] = valid ? (pos ? t : u) : 0.f; om[i] = valid ? (pos ? u : t) : 1.f; }
        float gp[4], pg[4], tot[4];
#pragma unroll
        for (int g = 0; g < 4; ++g) { gp[g] = (om[4 * g] * om[4 * g + 1]) * (om[4 * g + 2] * om[4 * g + 3]); pg[g] = __shfl_xor(gp[g], 32); tot[g] = gp[g] * pg[g]; }
        float T[4]; T[3] = 1.f; T[2] = tot[3]; T[1] = tot[3] * tot[2]; T[0] = T[1] * tot[1];
        float w[16];
#pragma unroll
        for (int g = 0; g < 4; ++g) { float run = R * T[g] * (hh == 0 ? pg[g] : 1.f);
#pragma unroll
            for (int i = 4 * g + 3; i >= 4 * g; --i) { w[i] = be[i] * run; run *= om[i]; } }
        R *= T[0] * tot[0];
#pragma unroll
        for (int sx = 0; sx < 2; ++sx) {
            v4u pw; pw.x = pk2(w[8 * sx], w[8 * sx + 1]); pw.y = pk2(w[8 * sx + 2], w[8 * sx + 3]); pw.z = pk2(w[8 * sx + 4], w[8 * sx + 5]); pw.w = pk2(w[8 * sx + 6], w[8 * sx + 7]);
            const bf16x8 wf = __builtin_bit_cast(bf16x8, pw);
#pragma unroll
            for (int db = 0; db < 4; ++db) o[db] = MFMA32(vf[sx][db], wf, o[db]);
        }
        if (__all(R < 1e-37f)) break;
    }
    const int orow_ = b * SEQ + q0 + r, ocol_ = h * HD + 4 * hh;
#pragma unroll
    for (int db = 0; db < 4; ++db)
#pragma unroll
        for (int q = 0; q < 4; q += 2) { v2u a, c; a.x = pk2(o[db][4 * q], o[db][4 * q + 1]); a.y = pk2(o[db][4 * q + 2], o[db][4 * q + 3]); c.x = pk2(o[db][4 * q + 4], o[db][4 * q + 5]); c.y = pk2(o[db][4 * q + 6], o[db][4 * q + 7]);
            unsigned ax = a.x, ay = a.y, cx = c.x, cy = c.y; swap_halves(ax, cx); swap_halves(ay, cy);
            v4u ov; ov.x = ax; ov.y = ay; ov.z = cx; ov.w = cy; *(v4u*)(O + pg8::tix(orow_, h * HD + 32 * db + 8 * (q + hh))) = ov; }
}
__device__ __forceinline__ void ssm_unit(int b, int g, const bf16* U, const bf16* Tg, const bf16* Eg, const bf16* Fg, const float* l16, const float* dsk, bf16* Y, unsigned char* Y8, LAS unsigned char* lds, int wave, int lane, int mode = 0  ) {
    LAS unsigned char* UL = lds;
    LAS unsigned char* LE16 = lds + 65536;
    LAS unsigned char* SP = lds + 98304;
    const int r = lane & 31, hh = lane >> 5, tid = wave * 64 + lane;
    const int nt3 = wave; const bf16* tb = Tg + ((size_t)(nt3 * 16) * 64 + lane) * 8; const bf16* fb = Fg + ((size_t)(nt3 * 8) * 64 + lane) * 8;
    bf16x8 tf[16], ff[8];
#pragma unroll
    for (int s = 0; s < 16; ++s) tf[s] = *(const bf16x8*)(tb + s * 512);
#pragma unroll
    for (int s2 = 0; s2 < 8; ++s2) ff[s2] = *(const bf16x8*)(fb + s2 * 512);
    { const v4u* ug = (const v4u*)(U + (size_t)(b * NG + g) * 4 * 16 * 64 * 8) + tid; v4u t[8];
#pragma unroll
      for (int i = 0; i < 8; ++i) t[i] = ug[512 * i];
#pragma unroll
      for (int i = 0; i < 8; ++i) *(LAS v4u*)(UL + (size_t)(tid + 512 * i) * 16) = t[i]; }
    __syncthreads();
    { const int mt = wave >> 1, nt0 = 2 * (wave & 1);
      f32x16 a0, a1;
#pragma unroll
      for (int i = 0; i < 16; ++i) { a0[i] = 0.f; a1[i] = 0.f; }
      const bf16* e0 = Eg + ((size_t)(nt0 * 16) * 64 + lane) * 8; const bf16* e1 = e0 + 16 * 512;
      const LAS unsigned char* ul = UL + ((size_t)(mt * 16) * 64 + lane) * 16;
#pragma unroll 8
      for (int s = 0; s < 16; ++s) { const bf16x8 uf = *(const LAS bf16x8*)(ul + s * 1024); const bf16x8 b0 = *(const bf16x8*)(e0 + s * 512), b1 = *(const bf16x8*)(e1 + s * 512);
          a0 = MFMA32(uf, b0, a0); a1 = MFMA32(uf, b1, a1); }
#pragma unroll
      for (int i = 0; i < 16; ++i) { LAS unsigned char* row = LE16 + (32 * mt + crow(i, hh)) * 256;
          *(LAS unsigned short*)(row + (32 * nt0 + r) * 2) = (unsigned short)(pk2(a0[i], 0.f) & 0xffffu); *(LAS unsigned short*)(row + (32 * nt0 + 32 + r) * 2) = (unsigned short)(pk2(a1[i], 0.f) & 0xffffu); } }
    __syncthreads();
    if (wave == 0 && mode < 2) { const int p = lane; const float lr = l16[2 * p], li = l16[2 * p + 1]; float sr = 0.f, si = 0.f;
#pragma unroll 1
        for (int k0 = 0; k0 < 128; k0 += 8) { unsigned le[8];
#pragma unroll
            for (int j = 0; j < 8; ++j) le[j] = *(const LAS unsigned*)(LE16 + (k0 + j) * 256 + 4 * p);
#pragma unroll
            for (int j = 0; j < 8; ++j) { *(LAS unsigned*)(SP + (k0 + j) * 272 + 4 * p) = pk2(sr, si);
                const float nr = lr * sr - li * si + bflo(le[j]), ni = lr * si + li * sr + bfhi(le[j]); sr = nr; si = ni; } } }
    __syncthreads();
    { const int nt = nt3;
      f32x4 dk[4];
#pragma unroll
      for (int q = 0; q < 4; ++q) dk[q] = *(const f32x4*)(dsk + 16 * g + 8 * (q & 1) + 4 * hh);
#pragma unroll 1
        for (int mt = 0; mt < 4; ++mt) { const int chunk = 32 * mt + r; const LAS unsigned char* ul = UL + ((size_t)(mt * 16) * 64 + lane) * 16;
            f32x16 acc;
#pragma unroll
            for (int i = 0; i < 16; ++i) acc[i] = 0.f;
#pragma unroll
            for (int s = 0; s < 16; ++s) { const bf16x8 bfr = *(const LAS bf16x8*)(ul + s * 1024); acc = MFMA32(tf[s], bfr, acc); }
#pragma unroll
            for (int s2 = 0; s2 < 8; ++s2) { const bf16x8 bfr = *(const LAS bf16x8*)(SP + chunk * 272 + 32 * s2 + 16 * hh); acc = MFMA32(ff[s2], bfr, acc); }
#pragma unroll
            for (int tq = 0; tq < 2; ++tq) { const int itok = 2 * nt + tq; unsigned ovx[2], ovy[2], o8[2];
#pragma unroll
                for (int e = 0; e < 2; ++e) { const int q = 2 * tq + e;
                    const v2u uw = *(const LAS v2u*)(UL + ((size_t)((mt * 16 + itok) * 64 + e * 32 + r)) * 16 + 8 * hh);
                    const float y0 = gelu_tanh(acc[4 * q] + dk[q].x * bflo(uw.x)), y1 = gelu_tanh(acc[4 * q + 1] + dk[q].y * bfhi(uw.x)), y2 = gelu_tanh(acc[4 * q + 2] + dk[q].z * bflo(uw.y)), y3 = gelu_tanh(acc[4 * q + 3] + dk[q].w * bfhi(uw.y));
                    ovx[e] = pk2(y0, y1); ovy[e] = pk2(y2, y3); o8[e] = pg8::pk4_fp8(y0 * pg8::F8_ASCALE, y1 * pg8::F8_ASCALE, y2 * pg8::F8_ASCALE, y3 * pg8::F8_ASCALE); }
                swap_halves(ovx[0], ovx[1]); swap_halves(ovy[0], ovy[1]); swap_halves(o8[0], o8[1]);
                v4u yo; yo.x = ovx[0]; yo.y = ovy[0]; yo.z = ovx[1]; yo.w = ovy[1]; v2u y8; y8.x = o8[0]; y8.y = o8[1];
                if (mode == 0) { *(v4u*)(Y + pg8::tix(b * SEQ + 16 * chunk + itok, 16 * g + 8 * hh)) = yo; *(v2u*)(Y8 + pg8::tix8(b * SEQ + 16 * chunk + itok, 16 * g + 8 * hh)) = y8; }
                else asm volatile("" :: "v"(yo.x), "v"(yo.y), "v"(yo.z), "v"(yo.w), "v"(y8.x), "v"(y8.y)); } } }
    __syncthreads();
}
#ifndef GEMM_ALIGN
#define GEMM_ALIGN true
#endif
#ifndef GEMM_SP2
#define GEMM_SP2 true
#endif
typedef __attribute__((address_space(4))) const Args* KArgP;
__device__ __forceinline__ KArgP kargs() { unsigned long long p = (unsigned long long)__builtin_amdgcn_kernarg_segment_ptr(); asm volatile("" : "+s"(p)); return (KArgP)p; }
#ifndef PH_MASK
#if defined(PROBE_NOMIX)
#define PH_MASK (0xFFFF & ~0x78)
#else
#define PH_MASK 0xFFFF
#endif
#endif
#define ON(i) (((PH_MASK) >> (i)) & 1)
#ifndef REP_P0
#define REP_P0 1
#endif
#ifndef REP_NORM
#define REP_NORM 1
#endif
#ifndef REP_IN
#define REP_IN 1
#endif
#ifndef REP_ATT
#define REP_ATT 1
#endif
#ifndef REP_SSM
#define REP_SSM 1
#endif
#ifndef SSM_PROBE_MODE
#define SSM_PROBE_MODE 0
#endif
#ifndef REP_FF1
#define REP_FF1 1
#endif
#ifndef REP_GB
#define REP_GB 1
#endif
#ifndef REP_P1
#define REP_P1 1
#endif
#ifndef REP_PE
#define REP_PE 1
#endif
#ifndef REP_BRS
#define REP_BRS 1
#endif
__global__ void __launch_bounds__(NWAVES * 64, 2) fwd(Args args_unused) {
    extern __shared__ __attribute__((aligned(16))) unsigned char lds_raw[];
    LAS unsigned char* lds = (LAS unsigned char*)lds_raw;
    volatile LAS unsigned* MISC = (volatile LAS unsigned*)(lds + MISC_OFF);
    const int wave_s = __builtin_amdgcn_readfirstlane(threadIdx.x >> 6);
    if (threadIdx.x < 64) MISC[threadIdx.x] = 0u;
    __syncthreads();
    int lo, hi;
    { KArgP A = kargs(); lo = A->ph_lo; hi = A->ph_hi;
      if (hi - lo > 1) (void)xcd_barrier_post((unsigned*)(A->ws + WS_CTL) + CW_BAR, MISC + 8); }
#define IN(k) (lo <= (k) && (k) < hi)
#define SEAM(k) do { if (IN(k) && IN((k) + 1)) { KArgP A_ = kargs(); XcdBarrier b_; b_.bar = (unsigned*)(A_->ws + WS_CTL) + CW_BAR; b_.x = xb_xcc_id(); b_.st = MISC + 8; b_.t0 = (wave_s == 0) && (pg8::lane_id() == 0); xcd_barrier(b_); } } while (0)
#define GWS int lane = pg8::lane_id(); asm volatile("" : "+v"(lane)); const int wave = wave_s, tid = wave * 64 + lane; (void)tid; \
    const int G = gridDim.x, bid = blockIdx.x, gw = bid * NWAVES + wave, NGW = G * NWAVES; (void)gw; (void)NGW; (void)bid; (void)G

    for (int rep_ = 0; rep_ < REP_P0; ++rep_) if (ON(0) && IN(0)) { KArgP A = kargs(); unsigned char* ws = A->ws; GWS; __syncthreads();
        LAS float* scr = (LAS float*)(lds + wave * 16640);
        tr_all(A, gw, NGW, scr, lane);
        { const float* P = A->in[I_P]; bf16* PB = (bf16*)(ws + WS_PB);
          for (int c = gw * 64 + lane; c < DEPTH * M * PLE / 8; c += NGW * 64) { const f32x4 a = *(const f32x4*)(P + (size_t)c * 8), b2 = *(const f32x4*)(P + (size_t)c * 8 + 4);
              v4u o; o.x = pk2(a.x, a.y); o.y = pk2(a.z, a.w); o.z = pk2(b2.x, b2.y); o.w = pk2(b2.z, b2.w);
              const int e_ = c * 8, L_ = e_ / (M * PLE), m_ = (e_ / PLE) % M, col_ = e_ % PLE; *(v4u*)(PB + (size_t)L_ * M * PLE + ((size_t)(col_ >> 6) * M + m_) * 64 + (col_ & 63)) = o; } }
#if defined(PROBE_STREAMCAST)
        {
            const int idx[9] = {I_WIN, I_WBRA, I_WGLU, I_WBRS, I_WO, I_WFF1, I_WFF2, I_WPG, I_WPLE};
            const size_t cnt[9] = {(size_t)DEPTH * DM * INW, (size_t)DEPTH * AW * DM, (size_t)DEPTH * SW * SW, (size_t)DEPTH * SW * DM, (size_t)DEPTH * DM * DM, (size_t)DEPTH * DM * DFF, (size_t)DEPTH * DFF * DM, (size_t)DEPTH * DM * DM, (size_t)DEPTH * PLE * DM};
            bf16* dead = (bf16*)(ws + WS_ACT); size_t wpos = 0;
#pragma unroll
            for (int q = 0; q < 9; ++q) { const float* src = A->in[idx[q]]; const size_t n8 = cnt[q] / 8;
                for (size_t c = (size_t)gw * 64 + lane; c < n8; c += (size_t)NGW * 64) { const f32x4 a = __builtin_nontemporal_load((const f32x4*)(src + c * 8)), b2 = __builtin_nontemporal_load((const f32x4*)(src + c * 8 + 4));
                    v4u o; o.x = pk2(a.x, a.y); o.y = pk2(a.z, a.w); o.z = pk2(b2.x, b2.y); o.w = pk2(b2.z, b2.w); __builtin_nontemporal_store(o, (v4u*)(dead + ((wpos + c * 8) % ((size_t)200 << 20)))); }
                wpos += cnt[q]; } }
#endif
        { const float* x = A->in[I_X]; bf16* Hb = (bf16*)(ws + WS_H); pg8::ssq_t* ss = (pg8::ssq_t*)(ws + WS_CTL + CTL_SS);
          for (int m = gw; m < M; m += NGW) prenorm_row(x + (size_t)m * DM, Hb, ws + WS_H8, m, ss + m, lane); }
        __syncthreads();
        for (int it = bid; it < DEPTH * NG; it += G) ssm_prep(A, it / NG, it % NG, lds, tid);
    }
    SEAM(0);
#pragma unroll 1
    for (int L = 0; L < DEPTH; ++L) {
        const int pb = 2 + PH_PER_LAYER * L;
#define LAYER_PTRS KArgP A = kargs(); unsigned char* ws = A->ws; GWS; unsigned char* wl = ws + WS_W + (size_t)L * W_LAYER; (void)wl; \
        unsigned char* H8c = ws + WS_H8 + (size_t)(L & 1) * M * DM; unsigned char* H8n = ws + WS_H8 + (size_t)((L & 1) ^ 1) * M * DM; (void)H8c; (void)H8n; \
        bf16* Hc = (bf16*)(ws + WS_H) + (size_t)(L & 1) * M * DM; bf16* Hn = (bf16*)(ws + WS_H) + (size_t)((L & 1) ^ 1) * M * DM; (void)Hc; (void)Hn;     \
        pg8::ssq_t* SSq = (pg8::ssq_t*)(ws + WS_CTL + CTL_SS); (void)SSq
        for (int rep_ = 0; rep_ < REP_IN; ++rep_) if (ON(3) && IN(pb + 0)) { LAYER_PTRS;
            { pg8::Gemm g{Hc, (const bf16*)(wl + WO_IN), M, INW / 2, DM}; QkvuOrder S; S.init(M, INW / 2, G, bid);
              pg8::EpiIn E{SSq + (0 * 2 + L) * M, lds + 131072, (bf16*)(ws + WS_ACT)};
              pg8::gemm_phase<pg8::EpiIn, QkvuOrder, GEMM_ALIGN, GEMM_SP2>(lds, g, S, E, wave); }
            { pg8::Gemm g{(const bf16*)H8c, (const bf16*)(wl + WO_IN + (64u << 20)), M, INW / 2, DM / 2}; pg8::StaticOrder S; S.init(M, INW / 2, G, bid);
              pg8::EpiGates E{SSq + (0 * 2 + L) * M, ws + WS_ACT + AO_SA};
              pg8::gemm_phase<pg8::EpiGates, pg8::StaticOrder, GEMM_ALIGN, GEMM_SP2>(lds, g, S, E, wave); }
        }
        SEAM(pb + 0);
        if (ON(4) && IN(pb + 1)) { LAYER_PTRS;
            { const bf16* Qb = (const bf16*)(ws + WS_ACT + AO_Q); const bf16* Kb = (const bf16*)(ws + WS_ACT + AO_K); const bf16* VPb = (const bf16*)(ws + WS_ACT + AO_VP); bf16* ATT = (bf16*)(ws + WS_ACT + AO_ATT);
              for (int rep_ = 0; rep_ < REP_ATT; ++rep_) for (int pu = bid; pu < BATCH * NH * 4; pu += G) { const int bh = pu >> 2, qp = pu & 3, b = bh >> 4, h = bh & 15;
                  attn_wave(Qb, Kb, VPb, ATT, b, h, 256 * (7 - qp) + 32 * wave, lane);
                  attn_wave(Qb, Kb, VPb, ATT, b, h, 256 * qp + 32 * wave, lane); } }
            __syncthreads();
            { unsigned char* sl = ws + WS_SSM + (size_t)L * SSM_LAYER; const float* dsk = A->in[I_DSKIP] + L * SW;
              for (int rep_ = 0; rep_ < REP_SSM; ++rep_) for (int su = bid; su < BATCH * NG; su += G) { const int b = su >> 7, g = su & 127;
                  ssm_unit(b, g, (const bf16*)(ws + WS_ACT + AO_U), (const bf16*)(sl + SO_T) + (size_t)g * 65536, (const bf16*)(sl + SO_E) + (size_t)g * 32768, (const bf16*)(sl + SO_F) + (size_t)g * 32768,
                           (const float*)(sl + SO_L16) + g * 128, dsk, (bf16*)(ws + WS_ACT + AO_Y), ws + WS_Y8, lds, wave, lane, rep_ == 0 ? 0 : SSM_PROBE_MODE); } }
        }
        SEAM(pb + 1);
        for (int rep_ = 0; rep_ < REP_GB; ++rep_) if (ON(5) && IN(pb + 2)) {
            { LAYER_PTRS; pg8::Gemm g{(const bf16*)(ws + WS_Y8), (const bf16*)(wl + WO_GLU), M, SW, SW / 2}; pg8::StaticOrder S; S.init(M, SW, G, bid);
              pg8::EpiB<2, true, true, true> E{(bf16*)(ws + WS_ACT + AO_SSM), (const bf16*)(ws + WS_ACT + AO_Y), nullptr, SW, nullptr};
              pg8::gemm_phase<pg8::EpiB<2, true, true, true>, pg8::StaticOrder, GEMM_ALIGN, GEMM_SP2>(lds, g, S, E, wave); }
            { LAYER_PTRS; pg8::Gemm g{(const bf16*)(ws + WS_ACT + AO_ATT), (const bf16*)(wl + WO_BRA), M, DM, AW}; pg8::StaticOrder S; S.init(M, DM, G, bid);
              pg8::EpiB<3, false, false> E{(bf16*)(ws + WS_ACT + AO_TMP), (const bf16*)(ws + WS_ACT + AO_SA), nullptr, DM, nullptr};
              pg8::gemm_phase<pg8::EpiB<3, false, false>, pg8::StaticOrder, GEMM_ALIGN, GEMM_SP2>(lds, g, S, E, wave); }
            { LAYER_PTRS; pg8::Gemm g{(const bf16*)(ws + WS_PB) + (size_t)L * M * PLE, (const bf16*)(wl + WO_PLE), M, DM, PLE}; pg8::StaticOrder S; S.init(M, DM, G, bid);
              pg8::EpiB<0, false, false> E{(bf16*)(ws + WS_PE) + (size_t)L * M * DM, nullptr, nullptr, DM, nullptr};
              pg8::gemm_phase<pg8::EpiB<0, false, false>, pg8::StaticOrder, GEMM_ALIGN, GEMM_SP2>(lds, g, S, E, wave); }
        }
        SEAM(pb + 2);
        for (int rep_ = 0; rep_ < REP_BRS; ++rep_) if (ON(6) && IN(pb + 3)) { LAYER_PTRS;
            pg8::Gemm g{(const bf16*)(ws + WS_ACT + AO_SSM), (const bf16*)(wl + WO_BRS), M, DM, SW}; pg8::StaticOrder S; S.init(M, DM, G, bid);
            pg8::EpiB<4, true, false> E{(bf16*)(ws + WS_ACT + AO_MRG), (const bf16*)(ws + WS_ACT + AO_TMP), (const bf16*)(ws + WS_ACT + AO_SS), DM, nullptr};
            pg8::gemm_phase<pg8::EpiB<4, true, false>, pg8::StaticOrder, GEMM_ALIGN, GEMM_SP2>(lds, g, S, E, wave);
        }
        SEAM(pb + 3);
        if (ON(7) && IN(pb + 4)) { LAYER_PTRS;
            pg8::Gemm g{(const bf16*)(ws + WS_ACT + AO_MRG), (const bf16*)(wl + WO_O), M, DM, DM}; pg8::StaticOrder S; S.init(M, DM, G, bid);
            pg8::EpiRes<false> E{Hc, Hc, nullptr, nullptr, SSq + (1 * 2 + L) * M, 1, nullptr};
            pg8::gemm_phase<pg8::EpiRes<false>, pg8::StaticOrder, GEMM_ALIGN, GEMM_SP2>(lds, g, S, E, wave);
        }
        SEAM(pb + 4);
        for (int rep_ = 0; rep_ < REP_FF1; ++rep_) if (ON(9) && IN(pb + 5)) { LAYER_PTRS;
            pg8::Gemm g{Hc, (const bf16*)(wl + WO_FF1), M, DFF, DM}; pg8::StaticOrder S; S.init(M, DFF, G, bid);
            pg8::EpiB<1, true, false> E{(bf16*)(ws + WS_MID), nullptr, nullptr, DFF, SSq + (1 * 2 + L) * M};
#if defined(PROBE_SPLIT_FF1)
            S.iend = 4;
            pg8::gemm_phase<pg8::EpiB<1, true, false>, pg8::StaticOrder, GEMM_ALIGN, GEMM_SP2>(lds, g, S, E, wave);
            { KArgP A_ = kargs(); XcdBarrier b_; b_.bar = (unsigned*)(A_->ws + WS_CTL) + CW_BAR; b_.x = xb_xcc_id(); b_.st = MISC + 8; b_.t0 = (wave_s == 0) && (pg8::lane_id() == 0); xcd_barrier(b_); }
            S.ibeg = 4; S.iend = 8;
#endif
            pg8::gemm_phase<pg8::EpiB<1, true, false>, pg8::StaticOrder, GEMM_ALIGN, GEMM_SP2>(lds, g, S, E, wave);
        }
        SEAM(pb + 5);
#if defined(PROBE_FF2X)
        if (ON(10) && IN(pb + 6)) { LAYER_PTRS;
            pg8::Gemm g{(const bf16*)(ws + WS_MID), (const bf16*)(wl + WO_FF2), M, DM, DFF}; pg8::StaticOrder S; S.init(M, DM, G, bid);
            pg8::EpiB<0, false, false> E{(bf16*)(ws + WS_ACT + AO_TMP), nullptr, nullptr, DM, nullptr};
            pg8::gemm_phase<pg8::EpiB<0, false, false>, pg8::StaticOrder, GEMM_ALIGN, GEMM_SP2>(lds, g, S, E, wave); }
#endif
#if defined(PROBE_L2X)
        if (ON(10) && IN(pb + 6)) { LAYER_PTRS;
            pg8::Gemm g{Hc, (const bf16*)(wl + WO_O), M, DM, -DM}; pg8::StaticOrder S; S.init(M, DM, G, bid);
            pg8::EpiB<0, false, false> E{(bf16*)(ws + WS_ACT + AO_TMP), nullptr, nullptr, DM, nullptr};
            pg8::gemm_phase<pg8::EpiB<0, false, false>, pg8::StaticOrder, GEMM_ALIGN, GEMM_SP2>(lds, g, S, E, wave); }
#endif
#if defined(PROBE_OX)
        if (ON(10) && IN(pb + 6)) { LAYER_PTRS;
            pg8::Gemm g{Hc, (const bf16*)(wl + WO_O), M, DM, DM}; pg8::StaticOrder S; S.init(M, DM, G, bid);
            pg8::EpiB<0, false, false> E{(bf16*)(ws + WS_ACT + AO_TMP), nullptr, nullptr, DM, nullptr};
            pg8::gemm_phase<pg8::EpiB<0, false, false>, pg8::StaticOrder, GEMM_ALIGN, GEMM_SP2>(lds, g, S, E, wave); }
#endif
        if (ON(10) && IN(pb + 6)) { LAYER_PTRS;
            pg8::Gemm g{(const bf16*)(ws + WS_MID), (const bf16*)(wl + WO_FF2), M, DM, DFF}; pg8::StaticOrder S; S.init(M, DM, G, bid);
            pg8::EpiRes<false> E{Hc, Hc, nullptr, nullptr, SSq + (2 * 2 + L) * M, 1, H8c};
            pg8::gemm_phase<pg8::EpiRes<false>, pg8::StaticOrder, GEMM_ALIGN, GEMM_SP2>(lds, g, S, E, wave);
        }
        SEAM(pb + 6);
        if (ON(12) && IN(pb + 7)) { LAYER_PTRS; const int Ln = (L + 1 < DEPTH) ? L + 1 : L;
            pg8::Gemm g{(const bf16*)H8c, (const bf16*)(wl + WO_PG), M, DM, DM / 2};     pg8::StaticOrder S; S.init(M, DM, G, bid);
            pg8::EpiRes<true> E{Hc, Hn, (const bf16*)(ws + WS_PE) + (size_t)L * M * DM, SSq + (2 * 2 + L) * M, SSq + (0 * 2 + Ln) * M, (L + 1 < DEPTH) ? 1 : 0, (L + 1 < DEPTH) ? H8n : nullptr};
            pg8::gemm_phase<pg8::EpiRes<true>, pg8::StaticOrder, GEMM_ALIGN, GEMM_SP2>(lds, g, S, E, wave);
        }
        SEAM(pb + 7);
    }
    if (ON(13) && IN(N_PHASES - 1)) { KArgP A = kargs(); unsigned char* ws = A->ws; GWS; const bf16* H = (const bf16*)(ws + WS_H) + (size_t)(DEPTH & 1) * M * DM; const float* gf = A->in[I_GFIN]; float* out = A->out;
        for (int m = gw; m < M; m += NGW) rms_row_f32(H, m, gf, out + (size_t)m * DM, lane); }
#undef IN
#undef SEAM
}

extern "C" void kernel_launch(void* const* d_in, const int* in_sizes, int n_in, void* d_out, int out_size, void* d_ws, size_t ws_size, hipStream_t stream) {
    static int grid = 0;
    if (grid == 0) {
        if (n_in != 23 || in_sizes[0] != M * DM || out_size != M * DM || ws_size < WS_END) { fprintf(stderr, "kernel_launch: unexpected shapes / workspace (n_in %d, ws %zu, need %zu); nothing launched\n", n_in, ws_size, (size_t)WS_END); grid = -1; return; }
        int dev = 0, cus = 0, per_cu = 0;
        if (hipGetDevice(&dev) != hipSuccess || hipDeviceGetAttribute(&cus, hipDeviceAttributeMultiprocessorCount, dev) != hipSuccess) { grid = -1; return; }
        if (hipFuncSetAttribute((const void*)fwd, hipFuncAttributeMaxDynamicSharedMemorySize, LDS_BYTES) != hipSuccess) { fprintf(stderr, "kernel_launch: hipFuncSetAttribute failed\n"); grid = -1; return; }
        if (hipOccupancyMaxActiveBlocksPerMultiprocessor(&per_cu, (const void*)fwd, NWAVES * 64, LDS_BYTES) != hipSuccess || per_cu < 1) fprintf(stderr, "kernel_launch: note: occupancy query says %d workgroups per CU\n", per_cu);
        (void)hipGetLastError();
        grid = cus;
    }
    if (grid < 0) return;
    if (hipMemsetAsync((char*)d_ws + WS_CTL, 0, CTL_ZERO_BYTES, stream) != hipSuccess) return;
    Args a{};
    for (int i = 0; i < 23; ++i) a.in[i] = (const float*)d_in[i];
    a.out = (float*)d_out; a.ws = (unsigned char*)d_ws;
#if MK_N_LAUNCHES == 1
    a.ph_lo = 0; a.ph_hi = N_PHASES; a.li = 0;
    hipLaunchKernelGGL(fwd, dim3(grid), dim3(NWAVES * 64), LDS_BYTES, stream, a);
#else
    for (int ph = 0; ph < N_PHASES; ++ph) { a.ph_lo = ph; a.ph_hi = ph + 1; a.li = ph;
        hipLaunchKernelGGL(fwd, dim3(grid), dim3(NWAVES * 64), LDS_BYTES, stream, a); }
#endif
}
```

```cpp
#include <hip/hip_runtime.h>
#include <cstdio>
#include <cstdint>
namespace pg8 {
#define PG8_LAS __attribute__((address_space(3)))
typedef unsigned short bf16_t;
typedef short bf16x8 __attribute__((ext_vector_type(8)));
typedef float f32x4 __attribute__((ext_vector_type(4)));
typedef unsigned u32x4 __attribute__((ext_vector_type(4)));
typedef int i32x8 __attribute__((ext_vector_type(8)));
constexpr int BM = 256, BK = 64, HALF = 128, HTB = HALF * BK * 2  , STAGE_BYTES = 8 * HTB, NXCD = 8, WGM = 8;

__host__ __device__ __forceinline__ int lds_byte(int r, int c) { const int st = (r >> 4) * 2 + (c >> 5), rr = r & 15, cc = c & 31, ob = rr * 64 + cc * 2; return st * 1024 + (ob ^ (((ob >> 9) & 1) << 5)); }
__host__ __device__ __forceinline__ void stage_rc(int b, int& R, int& C) { const int st = b / 1024, sb = b % 1024, swz = sb ^ (((sb >> 9) & 1) << 5); R = (st >> 1) * 16 + swz / 64; C = (st & 1) * 32 + (swz % 64) / 2; }
__host__ __device__ __forceinline__ int perm32(int rho) { const int n = rho >> 4, i = rho & 15; return 8 * (i >> 2) + 4 * n + (i & 3); }

__device__ __forceinline__ int lane_id() { unsigned z = 0u; asm volatile("" : "+v"(z)); return (int)__builtin_amdgcn_mbcnt_hi(~0u, __builtin_amdgcn_mbcnt_lo(~0u, z)); }
struct Unit { int pm, pn; };
struct Gemm { const bf16_t* A; const bf16_t* Bt; int M, N, K; };
__host__ __device__ __forceinline__ size_t tix(int row, int col) { return ((size_t)(col >> 6) * 8192 + row) * 64 + (col & 63); }

struct StaticOrder {
    int nM, nN, nwg, G, c, ibeg, iend;
    __host__ __device__ void init(int M, int N, int G_, int c_) { nM = M / BM; nN = N / BM; nwg = nM * nN; G = G_; c = c_; ibeg = 0; iend = 0x7fffffff; }
    __host__ __device__ bool next(int i, Unit& u) const {
        i += ibeg; if (i >= iend) return false;
        const long L = (long)i * G + c; if (L >= nwg) return false;
        int wgid = (int)L; { const int q = nwg / NXCD, r = nwg % NXCD, xcd = wgid % NXCD, off = wgid / NXCD; wgid = (xcd < r ? xcd * (q + 1) : r * (q + 1) + (xcd - r) * q) + off; }
        const int nig = WGM * nN, gid = wgid / nig, fm = gid * WGM, gsz = (nM - fm) < WGM ? (nM - fm) : WGM;
        u.pm = fm + ((wgid % nig) % gsz); u.pn = (wgid % nig) / gsz; return true;
    }
    __device__ __forceinline__ void a_ready(const Unit&) const {}
    __device__ __forceinline__ void done(const Unit&) const {}
};

typedef float f32x2c __attribute__((ext_vector_type(2)));
typedef __bf16 bf16x2c __attribute__((ext_vector_type(2)));
__device__ __forceinline__ unsigned cvt_pk_bf16(float lo, float hi) { const f32x2c v = {lo, hi}; return __builtin_bit_cast(unsigned, __builtin_convertvector(v, bf16x2c)); }
typedef float f32x2 __attribute__((ext_vector_type(2)));
typedef unsigned u32x2 __attribute__((ext_vector_type(2)));
__device__ __forceinline__ float bf_lo(unsigned w) { return __uint_as_float(w << 16); }
__device__ __forceinline__ float bf_hi(unsigned w) { return __uint_as_float(w & 0xffff0000u); }
typedef unsigned long long ssq_t;
__device__ __forceinline__ ssq_t ss_enc(float s) { return (ssq_t)(s * 16777216.0f); }
__device__ __forceinline__ float ss_dec(ssq_t v) { return (float)v * (1.0f / 16777216.0f); }
__device__ __forceinline__ unsigned q8(float s) { return (unsigned)(s * 255.0f + 0.5f); }
__device__ __forceinline__ unsigned pack4q(float a, float b, float c, float d) { return q8(a) | (q8(b) << 8) | (q8(c) << 16) | (q8(d) << 24); }
constexpr float F8_ASCALE = 8.0f, F8_WSCALE = 512.0f, F8_UNSCALE = 1.0f / 4096.0f;
__device__ __forceinline__ unsigned pk4_fp8(float a, float b, float c, float d) { unsigned w = 0u; w = __builtin_amdgcn_cvt_pk_fp8_f32(a, b, w, false); w = __builtin_amdgcn_cvt_pk_fp8_f32(c, d, w, true); return w; }
__host__ __device__ __forceinline__ size_t tix8(int row, int col) { return ((size_t)(col >> 7) * 8192 + row) * 128 + (col & 127); }
__device__ __forceinline__ float sigm(float x) { return __builtin_amdgcn_rcpf(1.0f + __expf(-x)); }

__device__ __forceinline__ int xp_pos(int r, int c) { return r * 64 + ((c + (r >> 2)) & 3) * 16; }
__device__ __forceinline__ int xp_pos8(int r, int c) { return r * 32 + ((c + (r >> 3)) & 3) * 8; }
__device__ __forceinline__ u32x4 xpose_ld(PG8_LAS unsigned char* tile, int fr, int fq, int ln, const u32x4 v) {
    *(PG8_LAS u32x4*)(tile + xp_pos(ln >> 2, ln & 3)) = v;
    return *(const PG8_LAS u32x4*)(tile + xp_pos(fr, fq));
}
__device__ __forceinline__ u32x4 xpose_st(PG8_LAS unsigned char* tile, int fr, int fq, int ln, const u32x4 w) {
    *(PG8_LAS u32x4*)(tile + xp_pos(fr, fq)) = w;
    return *(const PG8_LAS u32x4*)(tile + xp_pos(ln >> 2, ln & 3));
}
struct EpiIn {
    static constexpr bool PERM = true, AFTER_DRAIN = false, FP8 = false, IDEMP = false;
    const ssq_t* ssin;
    PG8_LAS unsigned char* vlds;
    bf16_t* ACT;
    __device__ __forceinline__ void operator()(const f32x4 (&acc)[2][2][4][2], const Unit& u, int wr, int wc, int fr, int fq) const {
        const int colt = u.pn * BM, row0 = u.pm * BM + wr * 64 + fr;
        const int b = (u.pm * BM) >> 11, s00 = ((u.pm * BM) & 2047) + wr * 64;
        float rr[2][4];
#pragma unroll
        for (int ai = 0; ai < 2; ++ai)
#pragma unroll
            for (int m = 0; m < 4; ++m) rr[ai][m] = __builtin_amdgcn_rsqf(ss_dec(ssin[row0 + ai * HALF + m * 16]) * (1.0f / 4096.0f) + 1e-6f);
        if (colt >= 4096 && colt < 6144) {
            const int h0 = (colt - 4096) >> 7; const int lane = fq * 16 + fr, rv = lane & 31, hv = lane >> 5;
            PG8_LAS unsigned char* vt = vlds + (wr * 4 + wc) * 2048;
#pragma unroll
            for (int ai = 0; ai < 2; ++ai)
#pragma unroll
                for (int m = 0; m < 4; ++m) { const int t = (s00 + ai * HALF + m * 16) >> 5, sx = m & 1;
#pragma unroll
                    for (int bj = 0; bj < 2; ++bj) { const f32x4 v0 = acc[ai][bj][m][0] * rr[ai][m], v1 = acc[ai][bj][m][1] * rr[ai][m];
                        u32x4 w; w.x = cvt_pk_bf16(v0[0], v0[1]); w.y = cvt_pk_bf16(v0[2], v0[3]); w.z = cvt_pk_bf16(v1[0], v1[1]); w.w = cvt_pk_bf16(v1[2], v1[3]);
                        PG8_LAS unsigned char* tb = vt + ((m * 2 + bj) & 1) * 1024;
                        *(PG8_LAS u32x4*)(tb + fr * 64 + fq * 16) = w;
                        unsigned short q[8];
#pragma unroll
                        for (int j = 0; j < 8; ++j) q[j] = *(const PG8_LAS unsigned short*)(tb + ((j & 3) + 4 * hv + 8 * (j >> 2)) * 64 + rv * 2);
                        u32x4 o; o.x = q[0] | ((unsigned)q[1] << 16); o.y = q[2] | ((unsigned)q[3] << 16); o.z = q[4] | ((unsigned)q[5] << 16); o.w = q[6] | ((unsigned)q[7] << 16);
                        *(u32x4*)(ACT + ((size_t)2 << 24) + ((((size_t)((b * 16 + h0 + bj) * 64 + t) * 4 + wc) * 2 + sx) * 64 + lane) * 8) = o; } }
        } else if (colt >= 6144) {
            const int g0 = ((colt - 6144) >> 4) + 2 * wc + (fq >> 1), hu = fq & 1;
#pragma unroll
            for (int ai = 0; ai < 2; ++ai)
#pragma unroll
                for (int m = 0; m < 4; ++m) { const int chunk = (s00 + ai * HALF + m * 16) >> 4, mt = chunk >> 5, ru = chunk & 31;
#pragma unroll
                    for (int bj = 0; bj < 2; ++bj) { const f32x4 v0 = acc[ai][bj][m][0] * rr[ai][m], v1 = acc[ai][bj][m][1] * rr[ai][m];
                        u32x4 w; w.x = cvt_pk_bf16(v0[0], v0[1]); w.y = cvt_pk_bf16(v0[2], v0[3]); w.z = cvt_pk_bf16(v1[0], v1[1]); w.w = cvt_pk_bf16(v1[2], v1[3]);
                        *(u32x4*)(ACT + ((size_t)3 << 24) + ((((size_t)((b * 128 + g0 + 8 * bj) * 4 + mt) * 16 + fr) * 64) + hu * 32 + ru) * 8) = w; } }
        } else {
            bf16_t* base = ACT + ((size_t)(colt >> 11) << 24); const int h0 = (colt & 2047) >> 7, hq = wc >> 1, ks = 4 * (wc & 1) + fq;
#pragma unroll
            for (int ai = 0; ai < 2; ++ai)
#pragma unroll
                for (int m = 0; m < 4; ++m) { const int t = (s00 + ai * HALF + m * 16) >> 5, rq = 16 * (m & 1) + fr;
#pragma unroll
                    for (int bj = 0; bj < 2; ++bj) { const f32x4 v0 = acc[ai][bj][m][0] * rr[ai][m], v1 = acc[ai][bj][m][1] * rr[ai][m];
                        u32x4 w; w.x = cvt_pk_bf16(v0[0], v0[1]); w.y = cvt_pk_bf16(v0[2], v0[3]); w.z = cvt_pk_bf16(v1[0], v1[1]); w.w = cvt_pk_bf16(v1[2], v1[3]);
                        *(u32x4*)(base + ((((size_t)((b * 16 + h0 + bj) * 64 + t) * 8 + ks) * 64) + hq * 32 + rq) * 8) = w; } }
        }
    }
};
struct EpiGates {
    static constexpr bool PERM = true, AFTER_DRAIN = false, FP8 = true, IDEMP = false;
    const ssq_t* ssin; unsigned char* SA8; PG8_LAS unsigned char* xl;
    __device__ __forceinline__ void operator()(const f32x4 (&acc)[2][2][4][2], const Unit& u, int wr, int wc, int fr, int fq) const {
        const int colt = u.pn * BM, row0 = u.pm * BM + wr * 64 + fr;
        unsigned char* base = SA8 + ((size_t)(colt >> 12) << 26); const int col0 = (colt & 4095) + wc * 32 + 8 * fq;
        float rs[2][4];
#pragma unroll
        for (int ai = 0; ai < 2; ++ai)
#pragma unroll
            for (int m = 0; m < 4; ++m) rs[ai][m] = ss_dec(ssin[row0 + ai * HALF + m * 16]);
#pragma unroll
        for (int ai = 0; ai < 2; ++ai)
#pragma unroll
            for (int m = 0; m < 4; ++m) { const int row = row0 + ai * HALF + m * 16; unsigned char* rowp = base + (size_t)row * 4096 + col0;
                const float rr = F8_UNSCALE * __builtin_amdgcn_rsqf(rs[ai][m] * (1.0f / 4096.0f) + 1e-6f);
#pragma unroll
                for (int bj = 0; bj < 2; ++bj) { const f32x4 v0 = acc[ai][bj][m][0] * rr, v1 = acc[ai][bj][m][1] * rr;
                    u32x2 w; w.x = pack4q(sigm(v0[0]), sigm(v0[1]), sigm(v0[2]), sigm(v0[3])); w.y = pack4q(sigm(v1[0]), sigm(v1[1]), sigm(v1[2]), sigm(v1[3]));
                    *(u32x2*)(rowp + bj * HALF) = w; } }
    }
};
template <int MODE, bool OT  , bool XT  , bool F8 = false  > struct EpiB {
    static constexpr bool PERM = true, AFTER_DRAIN = false, FP8 = F8, IDEMP = (MODE == 1);
    bf16_t* O; const bf16_t* X; const bf16_t* Y; int ldc; const ssq_t* ssin; PG8_LAS unsigned char* xl;
    __device__ __forceinline__ void operator()(const f32x4 (&acc)[2][2][4][2], const Unit& u, int wr, int wc, int fr, int fq) const { body<true>(acc, u, wr, wc, fr, fq); }
    template <bool ST> __device__ __forceinline__ void body(const f32x4 (&acc)[2][2][4][2], const Unit& u, int wr, int wc, int fr, int fq) const {
        const int row0 = u.pm * BM + wr * 64 + fr, col0 = u.pn * BM + wc * 32 + 8 * fq;
        float r2a[2][4];
        if (MODE == 1) {
#pragma unroll
            for (int ai = 0; ai < 2; ++ai)
#pragma unroll
                for (int m = 0; m < 4; ++m) r2a[ai][m] = ss_dec(ssin[row0 + ai * HALF + m * 16]); }
#pragma unroll
        for (int ai = 0; ai < 2; ++ai) {
            u32x4 xw[4][2], yw[4][2]; float r2[4];
#pragma unroll
            for (int m = 0; m < 4; ++m) { const size_t off = (size_t)(row0 + ai * HALF + m * 16) * ldc + col0;
                r2[m] = 1.f; if (MODE == 1) r2[m] = r2a[ai][m];
#pragma unroll
                for (int bj = 0; bj < 2; ++bj) {
                    if (MODE == 3) { const u32x2 g8 = *(const u32x2*)((const unsigned char*)X + off + bj * HALF); xw[m][bj] = (u32x4){g8.x, g8.y, 0u, 0u}; }
                    else if (MODE >= 2) xw[m][bj] = *(const u32x4*)(X + (XT ? tix(row0 + ai * HALF + m * 16, col0 + bj * HALF) : off + bj * HALF));
                    if (MODE == 4) { const u32x2 g8 = *(const u32x2*)((const unsigned char*)Y + off + bj * HALF); yw[m][bj] = (u32x4){g8.x, g8.y, 0u, 0u}; } } }
#pragma unroll
            for (int m = 0; m < 4; ++m) { const size_t off = (size_t)(row0 + ai * HALF + m * 16) * ldc + col0;
                if (MODE == 1) r2[m] = __builtin_amdgcn_rcpf(r2[m] * (1.0f / 4096.0f) + 1e-6f);
#pragma unroll
                for (int bj = 0; bj < 2; ++bj) { float v[8];
#pragma unroll
                    for (int j = 0; j < 4; ++j) { v[j] = acc[ai][bj][m][0][j]; v[4 + j] = acc[ai][bj][m][1][j]; }
                    if (MODE == 1) {
#pragma unroll
                        for (int j = 0; j < 8; ++j) { const float t = fmaxf(v[j], 0.f); v[j] = t * t * r2[m]; } }
                    if (MODE >= 2) { const u32x4 xq = xw[m][bj]; float x[8];
                        if (MODE == 3) {
#pragma unroll
                            for (int j = 0; j < 4; ++j) { x[j] = (float)((xq.x >> (8 * j)) & 0xffu) * (1.0f / 255.0f); x[4 + j] = (float)((xq.y >> (8 * j)) & 0xffu) * (1.0f / 255.0f); } }
                        else { x[0] = bf_lo(xq.x); x[1] = bf_hi(xq.x); x[2] = bf_lo(xq.y); x[3] = bf_hi(xq.y); x[4] = bf_lo(xq.z); x[5] = bf_hi(xq.z); x[6] = bf_lo(xq.w); x[7] = bf_hi(xq.w); }
                        if (MODE == 2) {
#pragma unroll
                            for (int j = 0; j < 8; ++j) v[j] = x[j] * sigm(F8 ? v[j] * F8_UNSCALE : v[j]); }
                        if (MODE == 3) {
#pragma unroll
                            for (int j = 0; j < 8; ++j) v[j] = x[j] * v[j]; }
                        if (MODE == 4) { const u32x4 yq = yw[m][bj]; float y[8];
#pragma unroll
                            for (int j = 0; j < 4; ++j) { y[j] = (float)((yq.x >> (8 * j)) & 0xffu) * (1.0f / 255.0f); y[4 + j] = (float)((yq.y >> (8 * j)) & 0xffu) * (1.0f / 255.0f); }
#pragma unroll
                            for (int j = 0; j < 8; ++j) v[j] = x[j] + y[j] * v[j]; } }
                    u32x4 w; w.x = cvt_pk_bf16(v[0], v[1]); w.y = cvt_pk_bf16(v[2], v[3]); w.z = cvt_pk_bf16(v[4], v[5]); w.w = cvt_pk_bf16(v[6], v[7]);
                    if (ST) { const int ln = fq * 16 + fr, rT = u.pm * BM + wr * 64 + ai * HALF + m * 16 + (ln >> 2), cT = u.pn * BM + wc * 32 + bj * HALF + 8 * (ln & 3);
                        const u32x4 wt = xpose_st(xl + (wr * 4 + wc) * 2048 + ((m * 2 + bj) & 1) * 1024, fr, fq, ln, w);
                        *(u32x4*)(O + (OT ? tix(rT, cT) : (size_t)rT * ldc + cT)) = wt; }
                    else asm volatile("" :: "v"(w.x), "v"(w.y), "v"(w.z), "v"(w.w)); } }
            asm volatile("" ::: "memory"); }
    }
};
template <bool GATE, bool H8 = true> struct EpiRes {
    static constexpr bool PERM = true, AFTER_DRAIN = false, FP8 = GATE, IDEMP = false;
#ifndef EPIRES_NB
#define EPIRES_NB 4
#endif
#ifndef EPIRES_NBG
#define EPIRES_NBG 2
#endif
    static constexpr int NB = GATE ? EPIRES_NBG : EPIRES_NB;
    const bf16_t* base; bf16_t* out; const bf16_t* pe; const ssq_t* ssin; ssq_t* ssout; int nx; unsigned char* h8out; PG8_LAS unsigned char* xl;
    __device__ __forceinline__ void operator()(const f32x4 (&acc)[2][2][4][2], const Unit& u, int wr, int wc, int fr, int fq) const {
        const int row0 = u.pm * BM + wr * 64 + fr, col0 = u.pn * BM + wc * 32 + 8 * fq;
        const bool NEXT = nx != 0;
#pragma unroll
        for (int g0 = 0; g0 < 8; g0 += NB) {
            u32x4 bb[NB][2], pp[NB][2]; float rin[NB];
#pragma unroll
            for (int gi = 0; gi < NB; ++gi) { const int ai = (g0 + gi) >> 2, m = (g0 + gi) & 3, row = row0 + ai * HALF + m * 16; const size_t off = (size_t)row * 4096 + col0;
                rin[gi] = 1.f; if (GATE) rin[gi] = ss_dec(ssin[row]);
#pragma unroll
                for (int bj = 0; bj < 2; ++bj) { const int ln = fq * 16 + fr, rT = row - fr + (ln >> 2), cT = col0 - 8 * fq + bj * HALF + 8 * (ln & 3);
                    bb[gi][bj] = *(const u32x4*)(base + tix(rT, cT)); if (GATE) pp[gi][bj] = *(const u32x4*)(pe + (size_t)rT * 4096 + cT); } }
#pragma unroll
            for (int gi = 0; gi < NB; ++gi) { const int ai = (g0 + gi) >> 2, m = (g0 + gi) & 3, row = row0 + ai * HALF + m * 16;
                if (GATE) rin[gi] = F8_UNSCALE * __builtin_amdgcn_rsqf(rin[gi] * (1.0f / 4096.0f) + 1e-6f);
                float sq = 0.f;
#pragma unroll
                for (int bj = 0; bj < 2; ++bj) { f32x4 a0 = acc[ai][bj][m][0], a1 = acc[ai][bj][m][1];
                    PG8_LAS unsigned char* tl = xl + (wr * 4 + wc) * 2048 + (bj & 1) * 1024; const int ln = fq * 16 + fr;
                    if (GATE) { const u32x4 pw = xpose_ld(tl, fr, fq, ln, pp[gi][bj]); const float rr = rin[gi];
                        a0[0] = bf_lo(pw.x) * sigm(a0[0] * rr); a0[1] = bf_hi(pw.x) * sigm(a0[1] * rr); a0[2] = bf_lo(pw.y) * sigm(a0[2] * rr); a0[3] = bf_hi(pw.y) * sigm(a0[3] * rr);
                        a1[0] = bf_lo(pw.z) * sigm(a1[0] * rr); a1[1] = bf_hi(pw.z) * sigm(a1[1] * rr); a1[2] = bf_lo(pw.w) * sigm(a1[2] * rr); a1[3] = bf_hi(pw.w) * sigm(a1[3] * rr); }
                    const u32x4 bw = xpose_ld(tl, fr, fq, ln, bb[gi][bj]);
                    const f32x4 h0 = (f32x4){bf_lo(bw.x), bf_hi(bw.x), bf_lo(bw.y), bf_hi(bw.y)} + a0, h1 = (f32x4){bf_lo(bw.z), bf_hi(bw.z), bf_lo(bw.w), bf_hi(bw.w)} + a1;
                    u32x4 hw; hw.x = cvt_pk_bf16(h0[0], h0[1]); hw.y = cvt_pk_bf16(h0[2], h0[3]); hw.z = cvt_pk_bf16(h1[0], h1[1]); hw.w = cvt_pk_bf16(h1[2], h1[3]);
                    const int rT = row - fr + (ln >> 2), cT = col0 - 8 * fq + bj * HALF + 8 * (ln & 3);
                    *(u32x4*)(out + tix(rT, cT)) = xpose_st(tl, fr, fq, ln, hw);
                    if (H8 && h8out) { u32x2 q; q.x = pk4_fp8(h0[0] * F8_ASCALE, h0[1] * F8_ASCALE, h0[2] * F8_ASCALE, h0[3] * F8_ASCALE); q.y = pk4_fp8(h1[0] * F8_ASCALE, h1[1] * F8_ASCALE, h1[2] * F8_ASCALE, h1[3] * F8_ASCALE);
                        *(PG8_LAS u32x2*)(tl + xp_pos8(fr, fq)) = q;
                        *(u32x2*)(h8out + tix8(rT, cT)) = *(const PG8_LAS u32x2*)(tl + xp_pos8(ln >> 2, ln & 3)); }
                    if (NEXT) sq += (h0[0] * h0[0] + h0[1] * h0[1]) + (h0[2] * h0[2] + h0[3] * h0[3]) + (h1[0] * h1[0] + h1[1] * h1[1]) + (h1[2] * h1[2] + h1[3] * h1[3]); }
                if (NEXT) { sq += __shfl_xor(sq, 16); sq += __shfl_xor(sq, 32); if (fq == 0) atomicAdd(ssout + row, ss_enc(sq)); } }
            asm volatile("" ::: "memory"); }
    }
};
template <class Epi, class Sched, bool ALIGN_EPI = false, bool SP2 = false>
__device__ __forceinline__ void gemm_phase(PG8_LAS unsigned char* lds, const Gemm g, const Sched& S, const Epi& E, const int wid_in  ) {
    int lane_ = lane_id(); asm volatile("" : "+v"(lane_));
    const int wid = wid_in, lane = lane_, tid = wid * 64 + lane, wr = wid >> 2, wc = wid & 3, fr = lane & 15, fq = lane >> 4;
    const int K = g.K < 0 ? -g.K : g.K, nt = K / BK;
    unsigned voffA[2], voffB[2];
#pragma unroll
    for (int i = 0; i < 2; ++i) { int R, C; stage_rc(tid * 16 + i * 8192, R, C); const int Rb = Epi::PERM ? ((R & ~31) + perm32(R & 31)) : R;
        voffA[i] = (unsigned)(R * BK + C) * 2u; voffB[i] = (unsigned)(Rb * BK + C) * 2u; }
    const size_t kstepA = (size_t)g.M * BK * 2, kstepB = (size_t)g.N * BK * 2;
    const size_t hstep = (size_t)HALF * BK * 2;
    const size_t tstep = 2 * hstep;
    const unsigned ldsw = (unsigned)wid * 1024u;
    const int aoff = lds_byte(wr * 64 + fr, fq * 8), boff = lds_byte(wc * 32 + fr, fq * 8);
#define PG8_SA(b, h) (((b) * 2 + (h)) * HTB)
#define PG8_SB(b, h) ((4 + (b) * 2 + (h)) * HTB)
#define PG8_STAGE(bufoff, gbase, voff) do { _Pragma("unroll") for (int _i = 0; _i < 2; ++_i) \
        __builtin_amdgcn_global_load_lds((const unsigned*)((const char*)(gbase) + _i * 8192 + (voff)[0]), (PG8_LAS unsigned*)(lds + (bufoff) + ldsw + _i * 8192), 16, 0, 0); } while (0)
#define PG8_LDA(dst, b, h) do { _Pragma("unroll") for (int m = 0; m < 4; ++m) _Pragma("unroll") for (int k = 0; k < 2; ++k) dst[m][k] = *(const PG8_LAS bf16x8*)(lds + PG8_SA(b, h) + aoff + m * 2048 + k * 1024); } while (0)
#define PG8_LDB(dst, b, h) do { _Pragma("unroll") for (int n = 0; n < 2; ++n) _Pragma("unroll") for (int k = 0; k < 2; ++k) dst[n][k] = *(const PG8_LAS bf16x8*)(lds + PG8_SB(b, h) + boff + n * 2048 + k * 1024); } while (0)
#define PG8_CAT(x, y) __builtin_bit_cast(i32x8, __builtin_shufflevector((x), (y), 0, 1, 2, 3, 4, 5, 6, 7, 8, 9, 10, 11, 12, 13, 14, 15))
#define PG8_MMA(ai, bj, At, Bt) do { __builtin_amdgcn_s_setprio(1); \
        if constexpr (Epi::FP8) { _Pragma("unroll") for (int m = 0; m < 4; ++m) _Pragma("unroll") for (int n = 0; n < 2; ++n) \
            asm volatile("v_mfma_f32_16x16x128_f8f6f4 %0, %1, %2, %0" : "+v"(acc[ai][bj][m][n]) : "v"(PG8_CAT(Bt[n][0], Bt[n][1])), "v"(PG8_CAT(At[m][0], At[m][1]))); } \
          \
          \
        else { _Pragma("unroll") for (int m = 0; m < 4; ++m) _Pragma("unroll") for (int n = 0; n < 2; ++n) _Pragma("unroll") for (int k = 0; k < 2; ++k) \
            acc[ai][bj][m][n] = __builtin_amdgcn_mfma_f32_16x16x32_bf16(Bt[n][k], At[m][k], acc[ai][bj][m][n], 0, 0, 0); } \
        __builtin_amdgcn_s_setprio(0); } while (0)
#ifndef PG8_RELAX
#define PG8_RELAX 0
#endif
#ifndef PROBE_EPI_STORE
#define PROBE_EPI_STORE 1
#endif
#if defined(PROBE_EPI_REPS)
#define PG8_EPI_AGAIN do { if constexpr (Epi::IDEMP) { _Pragma("unroll 1") for (int r_ = 0; r_ < PROBE_EPI_REPS; ++r_) { asm volatile("" ::: "memory"); int l3 = lane_id(); asm volatile("" : "+v"(l3)); E.template body<(PROBE_EPI_STORE != 0)>(acc, cur, wr, wc, l3 & 15, l3 >> 4); } } } while (0)
#else
#define PG8_EPI_AGAIN do { } while (0)
#endif
#define PG8_WAIT_V(n) asm volatile("s_waitcnt vmcnt(" #n ")" ::: "memory")
#define PG8_WAIT_L(n) asm volatile("s_waitcnt lgkmcnt(" #n ")" ::: "memory")
#define PG8_BAR __builtin_amdgcn_s_barrier()
#define PG8_SCHED __builtin_amdgcn_sched_barrier(0)
    Unit cur, nxt; int ui = 0;
    if (!S.next(0, cur)) return;
    f32x4 acc[2][2][4][2];
#pragma unroll
    for (int a = 0; a < 2; ++a)
#pragma unroll
        for (int b = 0; b < 2; ++b)
#pragma unroll
            for (int m = 0; m < 4; ++m)
#pragma unroll
                for (int n = 0; n < 2; ++n) acc[a][b][m][n] = (f32x4){0.f, 0.f, 0.f, 0.f};
    bf16x8 At[4][2], B0[2][2], B1[2][2];
    const size_t tstepA = (g.K < 0) ? 0 : tstep, tstepB = tstepA;
    const char* cA = (const char*)g.A + (size_t)cur.pm * tstepA; const char* cB = (const char*)g.Bt + (size_t)cur.pn * tstepB;
    S.a_ready(cur);
    if constexpr (SP2) {
        PG8_STAGE(PG8_SB(0, 0), cB, voffB); PG8_STAGE(PG8_SB(0, 1), cB + hstep, voffB); PG8_STAGE(PG8_SA(0, 0), cA, voffA); PG8_STAGE(PG8_SA(0, 1), cA + hstep, voffA);
        if (wr == 1) PG8_BAR;
        PG8_WAIT_V(2); PG8_BAR;
        PG8_STAGE(PG8_SB(1, 0), cB + kstepB, voffB); PG8_STAGE(PG8_SA(1, 0), cA + kstepA, voffA); PG8_STAGE(PG8_SB(1, 1), cB + hstep + kstepB, voffB);
        PG8_WAIT_V(6); PG8_BAR;
    } else {
        PG8_STAGE(PG8_SB(0, 0), cB, voffB); PG8_STAGE(PG8_SA(0, 0), cA, voffA); PG8_STAGE(PG8_SB(0, 1), cB + hstep, voffB); PG8_STAGE(PG8_SA(0, 1), cA + hstep, voffA);
        if (wr == 1) PG8_BAR;
        PG8_WAIT_V(4); PG8_BAR;
        PG8_STAGE(PG8_SB(1, 0), cB + kstepB, voffB); PG8_STAGE(PG8_SA(1, 0), cA + kstepA, voffA); PG8_STAGE(PG8_SB(1, 1), cB + hstep + kstepB, voffB);
        PG8_WAIT_V(6); PG8_BAR;
    }
    for (;;) {
        const bool has_next = S.next(ui + 1, nxt);
        const char* nA = has_next ? (const char*)g.A + (size_t)nxt.pm * tstepA : cA; const char* nB = has_next ? (const char*)g.Bt + (size_t)nxt.pn * tstepB : cB;
#pragma unroll 1
        for (int t = 0; t < nt; t += 2) {
            const bool last = (t == nt - 2);
            const char* a1 = cA + (size_t)(t + 1) * kstepA;
            const char* a2 = last ? nA : cA + (size_t)(t + 2) * kstepA; const char* b2 = last ? nB : cB + (size_t)(t + 2) * kstepB;
            const char* a3 = a2 + kstepA; const char* b3 = b2 + kstepB;
            if (last && has_next) S.a_ready(nxt);
            if constexpr (SP2) {
            const bool relax = PG8_RELAX && t == 0 && ui > 0;
            PG8_LDB(B0, 0, 0); PG8_LDB(B1, 0, 1); PG8_SCHED; PG8_LDA(At, 0, 0); PG8_STAGE(PG8_SA(1, 1), a1 + hstep, voffA);
            if (relax) PG8_WAIT_V(24); else PG8_WAIT_V(8);
            PG8_WAIT_L(0); PG8_BAR; PG8_MMA(0, 0, At, B0); PG8_MMA(0, 1, At, B1); PG8_BAR; PG8_SCHED;
            PG8_LDA(At, 0, 1); PG8_STAGE(PG8_SB(0, 0), b2, voffB); PG8_STAGE(PG8_SB(0, 1), b2 + hstep, voffB); PG8_STAGE(PG8_SA(0, 0), a2, voffA);
            if (relax) PG8_WAIT_V(24); else PG8_WAIT_V(8);
            PG8_WAIT_L(0); PG8_BAR; PG8_MMA(1, 0, At, B0); PG8_MMA(1, 1, At, B1); PG8_BAR; PG8_SCHED;
            PG8_LDB(B0, 1, 0); PG8_LDB(B1, 1, 1); PG8_SCHED; PG8_LDA(At, 1, 0); PG8_STAGE(PG8_SA(0, 1), a2 + hstep, voffA);
            PG8_WAIT_V(8); PG8_WAIT_L(0); PG8_BAR; PG8_MMA(0, 0, At, B0); PG8_MMA(0, 1, At, B1); PG8_BAR; PG8_SCHED;
            PG8_LDA(At, 1, 1); PG8_STAGE(PG8_SB(1, 0), b3, voffB); PG8_STAGE(PG8_SB(1, 1), b3 + hstep, voffB); PG8_STAGE(PG8_SA(1, 0), a3, voffA);
            PG8_WAIT_V(8); PG8_WAIT_L(0); PG8_BAR; PG8_MMA(1, 0, At, B0); PG8_MMA(1, 1, At, B1); PG8_BAR; PG8_SCHED;
            } else {
            PG8_LDB(B0, 0, 0); PG8_SCHED; PG8_LDA(At, 0, 0); PG8_STAGE(PG8_SA(1, 1), a1 + hstep, voffA);
            PG8_WAIT_L(8); PG8_BAR; PG8_WAIT_L(0); PG8_MMA(0, 0, At, B0); PG8_BAR; PG8_SCHED;
            PG8_LDB(B1, 0, 1); PG8_STAGE(PG8_SB(0, 0), b2, voffB);
            PG8_BAR; PG8_WAIT_L(0); PG8_MMA(0, 1, At, B1); PG8_BAR;
            PG8_LDA(At, 0, 1); PG8_STAGE(PG8_SA(0, 0), a2, voffA);
            PG8_BAR; PG8_WAIT_L(0); PG8_MMA(1, 0, At, B0); PG8_BAR; PG8_SCHED;
            PG8_STAGE(PG8_SB(0, 1), b2 + hstep, voffB);
            PG8_WAIT_V(6); PG8_BAR; PG8_MMA(1, 1, At, B1); PG8_BAR;
            PG8_LDB(B0, 1, 0); PG8_SCHED; PG8_LDA(At, 1, 0); PG8_STAGE(PG8_SA(0, 1), a2 + hstep, voffA);
            PG8_WAIT_L(8); PG8_BAR; PG8_WAIT_L(0); PG8_MMA(0, 0, At, B0); PG8_BAR; PG8_SCHED;
            PG8_LDB(B1, 1, 1); PG8_STAGE(PG8_SB(1, 0), b3, voffB);
            PG8_BAR; PG8_WAIT_L(0); PG8_MMA(0, 1, At, B1); PG8_BAR;
            PG8_LDA(At, 1, 1); PG8_STAGE(PG8_SA(1, 0), a3, voffA);
            PG8_BAR; PG8_WAIT_L(0); PG8_MMA(1, 0, At, B0); PG8_BAR; PG8_SCHED;
            PG8_STAGE(PG8_SB(1, 1), b3 + hstep, voffB);
            PG8_WAIT_V(6); PG8_BAR; PG8_MMA(1, 1, At, B1); PG8_BAR;
            }
        }
        if constexpr (ALIGN_EPI) { if (wr == 0) PG8_BAR; }
        if constexpr (Epi::FP8) asm volatile("s_nop 15\n\ts_nop 15" ::: "memory");
        if constexpr (!Epi::AFTER_DRAIN) { int l2 = lane_id(); asm volatile("" : "+v"(l2)); E(acc, cur, wr, wc, l2 & 15, l2 >> 4); PG8_EPI_AGAIN; S.done(cur); }
        if (!has_next) break;
#pragma unroll
        for (int a = 0; a < 2; ++a)
#pragma unroll
            for (int b = 0; b < 2; ++b)
#pragma unroll
                for (int m = 0; m < 4; ++m)
#pragma unroll
                    for (int n = 0; n < 2; ++n) acc[a][b][m][n] = (f32x4){0.f, 0.f, 0.f, 0.f};
        cur = nxt; cA = nA; cB = nB; ++ui;
        if constexpr (ALIGN_EPI) { if (wr == 1) PG8_BAR; }
    }
    PG8_WAIT_V(0);
    if constexpr (!ALIGN_EPI) { if (wr == 0) PG8_BAR; }
    PG8_BAR;
    if constexpr (Epi::AFTER_DRAIN) { E.fused(acc, cur, wr, wc, fr, fq, lds, wid, lane); S.done(cur); }
#undef PG8_SA
#undef PG8_SB
#undef PG8_STAGE
#undef PG8_LDA
#undef PG8_LDB
#undef PG8_MMA
#undef PG8_CAT
#undef PG8_WAIT_V
#undef PG8_WAIT_L
#undef PG8_BAR
#undef PG8_SCHED
}
}
constexpr int NWAVES = 8;
constexpr int BATCH = 4, SEQ = 2048, DM = 4096, DEPTH = 2, AW = 2048, NH = 16, HD = 128, SW = 2048, NG = 128, NP = 64, NC = 16, DFF = 16384, PLE = 256, INW = 16384;
constexpr int M = BATCH * SEQ;
constexpr float RMS_EPS = 1e-6f;
#ifndef MK_N_LAUNCHES
#define MK_N_LAUNCHES 1
#endif
constexpr int PH_PER_LAYER = 8, N_PHASES = 2 + DEPTH * PH_PER_LAYER + 1;

constexpr size_t MiB = 1u << 20;
constexpr size_t WS_CTL = 0, CTL_ZERO_BYTES = 1 * MiB;
constexpr size_t WS_W = 1 * MiB, W_LAYER = 490 * MiB;
constexpr size_t WO_IN = 0, WO_BRA = 128 * MiB, WO_GLU = 144 * MiB, WO_BRS = 152 * MiB, WO_O = 168 * MiB, WO_FF1 = 200 * MiB, WO_FF2 = 328 * MiB, WO_PG = 456 * MiB, WO_PLE = 488 * MiB;
constexpr size_t WS_SSM = WS_W + 2 * W_LAYER, SSM_LAYER = 33 * MiB;
constexpr size_t SO_T = 0, SO_E = 16 * MiB, SO_F = 24 * MiB, SO_L16 = 32 * MiB;
constexpr size_t WS_H = WS_SSM + 2 * SSM_LAYER;
constexpr size_t WS_PB = WS_H + 128 * MiB;
constexpr size_t WS_PE = WS_PB + 8 * MiB;
constexpr size_t WS_ACT = WS_PE + 128 * MiB;
constexpr size_t AO_Q = 0, AO_K = 32 * MiB, AO_VP = 64 * MiB, AO_U = 96 * MiB, AO_ATT = 128 * MiB, AO_Y = 160 * MiB, AO_SSM = 192 * MiB, AO_SA = 224 * MiB, AO_SS = 288 * MiB, AO_TMP = 352 * MiB, AO_MRG = 416 * MiB;
static_assert(AO_Q == 0 && AO_K == 32 * MiB && AO_VP == 64 * MiB && AO_U == 96 * MiB && AO_SA == 224 * MiB && AO_SS == 288 * MiB, "EpiIn's pointer arithmetic");
constexpr size_t WS_MID = WS_ACT;
constexpr size_t WS_H8 = WS_ACT + 480 * MiB;
constexpr size_t WS_Y8 = WS_H8 + 64 * MiB;
constexpr size_t WS_END = WS_Y8 + 16 * MiB;
constexpr size_t CTL_SS = 256 * 1024;
constexpr int CW_BAR = 4096;

constexpr int LDS_BYTES = 155648;
constexpr int MISC_OFF = LDS_BYTES - 256;

#define GAS __attribute__((address_space(1)))
#define LAS __attribute__((address_space(3)))
typedef unsigned short bf16;
typedef unsigned v4u __attribute__((ext_vector_type(4)));
typedef unsigned v2u __attribute__((ext_vector_type(2)));
typedef float f32x4 __attribute__((ext_vector_type(4)));
typedef float f32x2 __attribute__((ext_vector_type(2)));
typedef float f32x16 __attribute__((ext_vector_type(16)));
typedef short bf16x8 __attribute__((ext_vector_type(8)));
typedef __bf16 bf16x2v __attribute__((ext_vector_type(2)));
typedef GAS unsigned gu32;
#define RLX_AGENT __ATOMIC_RELAXED, __HIP_MEMORY_SCOPE_AGENT
#define LDS_WAIT() asm volatile("s_waitcnt lgkmcnt(0)" ::: "memory")
#define VM_WAIT() asm volatile("s_waitcnt vmcnt(0)" ::: "memory")
#define MFMA32(a, b, c) __builtin_amdgcn_mfma_f32_32x32x16_bf16((a), (b), (c), 0, 0, 0)
__device__ __forceinline__ unsigned pk2(float lo, float hi) { const f32x2 v = {lo, hi}; return __builtin_bit_cast(unsigned, __builtin_convertvector(v, bf16x2v)); }
__device__ __forceinline__ float bflo(unsigned w) { return __uint_as_float(w << 16); }
__device__ __forceinline__ float bfhi(unsigned w) { return __uint_as_float(w & 0xffff0000u); }
__device__ __forceinline__ int crow(int i, int h) { return (i & 3) + 8 * (i >> 2) + 4 * h; }
#define XB_TMO      128
#define XB_XCNT(j)  (256  + 64 * (j))
#define XB_XSUB(j)  (1280 + 64 * (j))
#define XB_XGEN(j)  (2304 + 64 * (j))
#define XB_TOP      3328
#define XB_TOPGEN   3392
#define XCD_BAR_WORDS 3456
#define XB_SPIN_CAP (1u << 18)

__device__ __forceinline__ unsigned xb_ld(unsigned* p)              { return __hip_atomic_load(p, __ATOMIC_RELAXED, __HIP_MEMORY_SCOPE_AGENT); }
__device__ __forceinline__ unsigned xb_add(unsigned* p, unsigned v) { return __hip_atomic_fetch_add(p, v, __ATOMIC_RELAXED, __HIP_MEMORY_SCOPE_AGENT); }
__device__ __forceinline__ unsigned xb_xcc_id() { return (unsigned)__builtin_amdgcn_s_getreg((3 << 11) | 20) & 0xFu; }
#define XB_SPIN(cond, bar) do { unsigned _sp = 0; while (cond) { __builtin_amdgcn_s_sleep(1); \
    if ((++_sp & 255u) == 0u) { if (xb_ld(&(bar)[XB_TMO])) break; if (_sp > XB_SPIN_CAP) { atomicAdd(&(bar)[XB_TMO], 1u); break; } } } } while (0)

struct XcdBarrier {
    unsigned* bar; unsigned x; bool t0;
    volatile LAS unsigned* st;
};

__device__ __forceinline__ XcdBarrier xcd_barrier_post(unsigned* bar, volatile LAS unsigned* st) {
    XcdBarrier b; b.bar = bar; b.x = xb_xcc_id(); b.st = st; b.t0 = (threadIdx.x == 0);
    if (threadIdx.x == 0) (void)xb_add(&bar[XB_XCNT(b.x)], 1u);
    return b;
}
__device__ __forceinline__ void xcd_barrier_complete(unsigned* bar, unsigned x, unsigned& nloc, unsigned& nx) {
    const unsigned G = gridDim.x * gridDim.y * gridDim.z;
    unsigned sum, cnt, mine, sp = 0u;
    for (;;) {
        sum = 0u; cnt = 0u; mine = 0u;
#pragma unroll
        for (unsigned j = 0; j < 16; ++j) { const unsigned c = xb_ld(&bar[XB_XCNT(j)]); sum += c; cnt += (c > 0u) ? 1u : 0u; mine = (j == x) ? c : mine; }
        if (sum == G) break;
        __builtin_amdgcn_s_sleep(1);
        if ((++sp & 255u) == 0u) { if (xb_ld(&bar[XB_TMO])) break; if (sp > XB_SPIN_CAP) { atomicAdd(&bar[XB_TMO], 1u); break; } }
    }
    nloc = mine > 0u ? mine : 1u; nx = cnt > 0u ? cnt : 1u;
}

__device__ __forceinline__ void xcd_barrier(const XcdBarrier& b) {
    asm volatile("s_waitcnt vmcnt(0)" ::: "memory");
    __syncthreads();
    if (b.t0) {
        unsigned* bar = b.bar;
        __builtin_amdgcn_s_waitcnt(0);
        unsigned nloc = b.st[0], nx = b.st[1];
        if (nloc == 0u) { xcd_barrier_complete(bar, b.x, nloc, nx); b.st[0] = nloc; b.st[1] = nx; }
        const unsigned old = xb_add(&bar[XB_XSUB(b.x)], 1u);
        const unsigned gen = old / nloc;
        if (old + 1u == (gen + 1u) * nloc) {
            __builtin_amdgcn_fence(__ATOMIC_RELEASE, "agent");
            asm volatile("s_waitcnt vmcnt(0)" ::: "memory");
            const unsigned og = xb_add(&bar[XB_TOP], 1u);
            const unsigned tg = og / nx;
            if (og + 1u == (tg + 1u) * nx) xb_add(&bar[XB_TOPGEN], 1u);
            else XB_SPIN(xb_ld(&bar[XB_TOPGEN]) == tg, bar);
            __builtin_amdgcn_fence(__ATOMIC_ACQUIRE, "agent");
            xb_add(&bar[XB_XGEN(b.x)], 1u);
            asm volatile("s_waitcnt vmcnt(0)" ::: "memory");
        } else {
            XB_SPIN(xb_ld(&bar[XB_XGEN(b.x)]) == gen, bar);
            __builtin_amdgcn_fence(__ATOMIC_ACQUIRE, "agent");
            asm volatile("s_waitcnt vmcnt(0)" ::: "memory");
        }
    }
    __syncthreads();
}

struct Args { const float* in[23]; float* out; unsigned char* ws; int ph_lo, ph_hi, li, pad; };
typedef __attribute__((address_space(4))) const Args* KArgP0;
enum { I_X = 0, I_P, I_GMIX, I_WIN, I_WBRA, I_LRE, I_LIM, I_LOGDT, I_BRE, I_BIM, I_CRE, I_CIM, I_DSKIP, I_WGLU, I_WBRS, I_WO, I_GMLP, I_WFF1, I_WFF2, I_GPLE, I_WPG, I_WPLE, I_GFIN };

__device__ __forceinline__ float wave_sum(float v) {
#pragma unroll
    for (int o = 1; o < 64; o <<= 1) v += __shfl_xor(v, o);
    return v;
}
struct TrDesc { const float* src; bf16* dst; const float* gk; int K; size_t N; int f8; };
constexpr int TR_IN = 16384, TR_BRA = 2048, TR_GLU = 1024, TR_BRS = 2048, TR_O = 4096, TR_FF1 = 16384, TR_FF2 = 16384, TR_PG = 4096, TR_PLE = 256;
constexpr int TR_LAYER = TR_IN + TR_BRA + TR_GLU + TR_BRS + TR_O + TR_FF1 + TR_FF2 + TR_PG + TR_PLE;
__device__ __forceinline__ TrDesc tr_desc(KArgP0 a, int it, int lane) {
    const int L = it / TR_LAYER; int r = it - L * TR_LAYER;
    unsigned char* wl = a->ws + WS_W + (size_t)L * W_LAYER;
    const float* W; int K, N; size_t wo; const float* gv = nullptr; int f8 = 0;
    int win = 0;
    if (r < TR_IN) { W = a->in[I_WIN] + (size_t)L * DM * INW; K = DM; N = INW; wo = WO_IN; gv = a->in[I_GMIX] + L * DM; win = 1; }
    else if ((r -= TR_IN) < TR_BRA) { W = a->in[I_WBRA] + (size_t)L * AW * DM; K = AW; N = DM; wo = WO_BRA; }
    else if ((r -= TR_BRA) < TR_GLU) { W = a->in[I_WGLU] + (size_t)L * SW * SW; K = SW; N = SW; wo = WO_GLU; f8 = 1; }
    else if ((r -= TR_GLU) < TR_BRS) { W = a->in[I_WBRS] + (size_t)L * SW * DM; K = SW; N = DM; wo = WO_BRS; }
    else if ((r -= TR_BRS) < TR_O) { W = a->in[I_WO] + (size_t)L * DM * DM; K = DM; N = DM; wo = WO_O; }
    else if ((r -= TR_O) < TR_FF1) { W = a->in[I_WFF1] + (size_t)L * DM * DFF; K = DM; N = DFF; wo = WO_FF1; gv = a->in[I_GMLP] + L * DM; }
    else if ((r -= TR_FF1) < TR_FF2) { W = a->in[I_WFF2] + (size_t)L * DFF * DM; K = DFF; N = DM; wo = WO_FF2; }
    else if ((r -= TR_FF2) < TR_PG) { W = a->in[I_WPG] + (size_t)L * DM * DM; K = DM; N = DM; wo = WO_PG; gv = a->in[I_GPLE] + L * DM; f8 = 1; }
    else { r -= TR_PG; W = a->in[I_WPLE] + (size_t)L * PLE * DM; K = PLE; N = DM; wo = WO_PLE; }
    const int nblk = N >> 6, kb = r / nblk, nb = r - kb * nblk, k0 = kb * 64, n0 = nb * 64;
    TrDesc t; t.src = W + (size_t)(k0 + (lane >> 4)) * N + n0 + 4 * (lane & 15); t.dst = (bf16*)(wl + wo) + ((size_t)kb * N + n0 + (lane >> 3)) * 64 + 8 * (lane & 7); t.K = 64; t.N = (size_t)N; t.gk = gv ? gv + k0 + 8 * (lane & 7) : nullptr; t.f8 = f8;
    if (f8) t.dst = (bf16*)((unsigned char*)(wl + wo) + ((size_t)(k0 >> 7) * N + n0 + (lane >> 3)) * 128 + (k0 & 127) + 8 * (lane & 7));
    if (win) {
        if (n0 < 8192) t.dst = (bf16*)(wl + wo) + ((size_t)kb * 8192 + n0 + (lane >> 3)) * 64 + 8 * (lane & 7);
        else { t.f8 = 1; t.dst = (bf16*)((unsigned char*)(wl + wo) + (64u << 20) + ((size_t)(k0 >> 7) * 8192 + (n0 - 8192) + (lane >> 3)) * 128 + (k0 & 127) + 8 * (lane & 7)); } }
    return t;
}
__device__ __forceinline__ void tr_load(f32x4 (&v)[16], const TrDesc& t) {
#pragma unroll
    for (int i = 0; i < 16; ++i) v[i] = __builtin_nontemporal_load((const f32x4*)(t.src + (size_t)(4 * i) * t.N));
}
__device__ __forceinline__ void tr_store(const f32x4 (&v)[16], const TrDesc& t, LAS float* scr, int lane) {
    LAS float* d = scr + (lane >> 4) * 65 + 4 * (lane & 15);
#pragma unroll
    for (int i = 0; i < 16; ++i) { LAS float* dd = d + (4 * i) * 65; dd[0] = v[i].x; dd[1] = v[i].y; dd[2] = v[i].z; dd[3] = v[i].w; }
    LDS_WAIT(); asm volatile("" ::: "memory");
    const LAS float* s0 = scr + (8 * (lane & 7)) * 65 + (lane >> 3);
    f32x4 g0 = {1.f, 1.f, 1.f, 1.f}, g1 = g0; if (t.gk) { g0 = *(const f32x4*)t.gk; g1 = *(const f32x4*)(t.gk + 4); }
    if (t.f8) { g0 = g0 * pg8::F8_WSCALE; g1 = g1 * pg8::F8_WSCALE; }
#pragma unroll
    for (int jj = 0; jj < 8; ++jj) { const LAS float* s = s0 + 8 * jj;
        if (t.f8) { v2u q; q.x = pg8::pk4_fp8(s[0] * g0.x, s[65] * g0.y, s[2 * 65] * g0.z, s[3 * 65] * g0.w); q.y = pg8::pk4_fp8(s[4 * 65] * g1.x, s[5 * 65] * g1.y, s[6 * 65] * g1.z, s[7 * 65] * g1.w);
            __builtin_nontemporal_store(q, (v2u*)(t.dst + (size_t)(8 * jj) * t.K)); continue; }
        v4u o; o.x = pk2(s[0] * g0.x, s[65] * g0.y); o.y = pk2(s[2 * 65] * g0.z, s[3 * 65] * g0.w); o.z = pk2(s[4 * 65] * g1.x, s[5 * 65] * g1.y); o.w = pk2(s[6 * 65] * g1.z, s[7 * 65] * g1.w);
        __builtin_nontemporal_store(o, (v4u*)(t.dst + (size_t)(8 * jj) * t.K)); }
    LDS_WAIT(); asm volatile("" ::: "memory");
}
__device__ __forceinline__ void tr_all(KArgP0 a, int gw, int NGW, LAS float* scr, int lane) {
    constexpr int NIT = DEPTH * TR_LAYER;
    int it = gw; if (it >= NIT) return;
    f32x4 va[16], vb[16];
    TrDesc ta = tr_desc(a, it, lane), tb = ta; tr_load(va, ta);
    for (;;) {
        const bool hb = (it + NGW < NIT); if (hb) { tb = tr_desc(a, it + NGW, lane); tr_load(vb, tb); }
        tr_store(va, ta, scr, lane); if (!hb) break; it += NGW;
        const bool ha = (it + NGW < NIT); if (ha) { ta = tr_desc(a, it + NGW, lane); tr_load(va, ta); }
        tr_store(vb, tb, scr, lane); if (!ha) break; it += NGW;
    }
}
__device__ __forceinline__ void tr_all_dyn(KArgP0 a, unsigned* ctr, volatile LAS unsigned* slot, int wave, LAS float* scr, int lane) {
    constexpr unsigned NIT = DEPTH * TR_LAYER;
    const bool lead = (wave == 0) && (lane == 0);
    if (lead) { slot[2] = atomicAdd(ctr, 16u); slot[1] = atomicAdd(ctr, 16u); }
    __syncthreads();
    unsigned base = slot[2];
    if (base >= NIT) return;
    f32x4 va[16], vb[16];
    TrDesc ta = tr_desc(a, (int)base + wave, lane), tb = ta; tr_load(va, ta);
    for (unsigned r = 0;; ++r) {
        unsigned nb2 = 0u; if (lead) nb2 = atomicAdd(ctr, 16u);
        tb = tr_desc(a, (int)base + 8 + wave, lane); tr_load(vb, tb);
        tr_store(va, ta, scr, lane);
        const unsigned nbase = slot[(r + 1) & 1]; const bool more = nbase < NIT;
        if (more) { ta = tr_desc(a, (int)nbase + wave, lane); tr_load(va, ta); }
        tr_store(vb, tb, scr, lane);
        if (lead) slot[r & 1] = nb2;
        __syncthreads();
        if (!more) break;
        base = nbase;
    }
}
#ifndef ROT_FF1
#define ROT_FF1 1
#endif
#ifndef ROT_IN
#define ROT_IN 0
#endif
struct RotOrder : pg8::StaticOrder {
    __device__ __forceinline__ bool next(int i, pg8::Unit& u) const {
        if (!pg8::StaticOrder::next(i, u)) return false;
        if (nM == 32 && nN == 16 && G == 256 && (i & 1)) { u.pm ^= 16; u.pn ^= 8; }
        if (ROT_FF1 && nM == 32 && nN == 64 && G == 256) { if (i & 1) u.pn ^= 32; if (i & 2) u.pm ^= 16; if (i & 4) u.pm ^= 8; }
        if (ROT_IN && nM == 32 && nN == 32 && G == 256) { if (i & 1) u.pn ^= 16; if (i & 2) u.pm ^= 16; }
        return true;
    }
};
struct HalfMOrder : pg8::StaticOrder {
    __device__ __forceinline__ bool next(int i, pg8::Unit& u) const {
        if (!(G == 256 && nM == 32 && nN == 16)) return pg8::StaticOrder::next(i, u);
        i += ibeg; if (i >= iend || i >= 2) return false;
        const int x = c & 7, loc = c >> 3;
        u.pm = i * 16 + (x & 1) * 8 + (loc & 7); u.pn = (x >> 1) * 4 + (loc >> 3); return true;
    }
};
struct QkvuOrder : pg8::StaticOrder {
    __device__ __forceinline__ bool next(int i, pg8::Unit& u) const {
        if (!pg8::StaticOrder::next(i, u)) return false;
        if (G == 256 && nN == 32 && (i & 1)) u.pn ^= 16;
        if (ROT_IN && G == 256 && nN == 32 && nM == 32 && (i & 2)) u.pm ^= 16;
        return true;
    }
};
__device__ __forceinline__ void ssm_prep(KArgP0 a, int L, int g, LAS unsigned char* lds, int tid) {
    LAS float* lamp = (LAS float*)lds;
    LAS float* bbar = lamp + 64 * 17 * 2;
    LAS float* ccv = bbar + 64 * 16 * 2;
    LAS float* Kd = ccv + 16 * 64 * 2;
    const int lg = L * NG + g;
    const float* lre = a->in[I_LRE] + lg * NP; const float* lim = a->in[I_LIM] + lg * NP;
    const float* bre = a->in[I_BRE] + (size_t)lg * NP * NC; const float* bim = a->in[I_BIM] + (size_t)lg * NP * NC;
    const float* cre = a->in[I_CRE] + (size_t)lg * NC * NP; const float* cim = a->in[I_CIM] + (size_t)lg * NC * NP;
    const float dt = expf(a->in[I_LOGDT][lg]);
    for (int t = tid; t < 64 * 17; t += 512) { const int p = t / 17, d = t - 17 * p; const float ar = lre[p] * dt * (float)d, th = lim[p] * dt * (float)d, e = expf(ar);
        lamp[2 * t] = e * cosf(th); lamp[2 * t + 1] = e * sinf(th); }
    for (int t = tid; t < 64 * 16; t += 512) { const int p = t >> 4; const float lr = lre[p], li = lim[p], ar = lr * dt, th = li * dt;
        const float ea = expf(ar), em1 = expm1f(ar), sn = sinf(th), cs = cosf(th), sh = sinf(0.5f * th);
        const float nr = em1 * cs - 2.f * sh * sh, ni = ea * sn, den = lr * lr + li * li;
        const float cr = (nr * lr + ni * li) / den, ci = (ni * lr - nr * li) / den;
        const float br = bre[t], bi = bim[t];
        bbar[2 * t] = cr * br - ci * bi; bbar[2 * t + 1] = cr * bi + ci * br;
        ccv[2 * t] = cre[t]; ccv[2 * t + 1] = cim[t]; }
    __syncthreads();
    for (int t = tid; t < 4096; t += 512) { const int d = t >> 8, c = (t >> 4) & 15, c2 = t & 15; float acc = 0.f;
        for (int p = 0; p < 64; ++p) { const float cr = ccv[2 * (c * 64 + p)], ci = ccv[2 * (c * 64 + p) + 1], lr = lamp[2 * (p * 17 + d)], li = lamp[2 * (p * 17 + d) + 1];
            const float br = bbar[2 * (p * 16 + c2)], bi = bbar[2 * (p * 16 + c2) + 1], xr = cr * lr - ci * li, xi = cr * li + ci * lr; acc += xr * br - xi * bi; }
        Kd[t] = acc; }
    __syncthreads();
    unsigned char* sl = a->ws + WS_SSM + (size_t)L * SSM_LAYER;
    bf16* Tg = (bf16*)(sl + SO_T) + (size_t)g * 256 * 256; bf16* Eg = (bf16*)(sl + SO_E) + (size_t)g * 128 * 256; bf16* Fg = (bf16*)(sl + SO_F) + (size_t)g * 256 * 128;
    for (int ch = tid; ch < 8192; ch += 512) { const int n = ch >> 5, kc = ch & 31, i = n >> 4, c = n & 15, j = kc >> 1, c20 = (kc & 1) * 8; float v[8];
#pragma unroll
        for (int e = 0; e < 8; ++e) v[e] = (j <= i) ? Kd[((i - j) * 16 + c) * 16 + c20 + e] : 0.f;
        v4u o; o.x = pk2(v[0], v[1]); o.y = pk2(v[2], v[3]); o.z = pk2(v[4], v[5]); o.w = pk2(v[6], v[7]); *(v4u*)(Tg + ((size_t)(((n >> 5) * 16 + (kc >> 1)) * 64) + (kc & 1) * 32 + (n & 31)) * 8) = o; }
    for (int ch = tid; ch < 4096; ch += 512) { const int n = ch >> 5, kc = ch & 31, p = n >> 1, ri = n & 1, j = kc >> 1, c20 = (kc & 1) * 8; float v[8];
        const float lr = lamp[2 * (p * 17 + 15 - j)], li = lamp[2 * (p * 17 + 15 - j) + 1];
#pragma unroll
        for (int e = 0; e < 8; ++e) { const float br = bbar[2 * (p * 16 + c20 + e)], bi = bbar[2 * (p * 16 + c20 + e) + 1]; v[e] = ri ? (lr * bi + li * br) : (lr * br - li * bi); }
        v4u o; o.x = pk2(v[0], v[1]); o.y = pk2(v[2], v[3]); o.z = pk2(v[4], v[5]); o.w = pk2(v[6], v[7]); *(v4u*)(Eg + ((size_t)(((n >> 5) * 16 + (kc >> 1)) * 64) + (kc & 1) * 32 + (n & 31)) * 8) = o; }
    for (int ch = tid; ch < 4096; ch += 512) { const int n = ch >> 4, kc = ch & 15, i = n >> 4, c = n & 15; float v[8];
#pragma unroll
        for (int e = 0; e < 8; ++e) { const int kk = 8 * kc + e, p = kk >> 1; const float cr = ccv[2 * (c * 64 + p)], ci = ccv[2 * (c * 64 + p) + 1], lr = lamp[2 * (p * 17 + i + 1)], li = lamp[2 * (p * 17 + i + 1) + 1];
            v[e] = (kk & 1) ? -(cr * li + ci * lr) : (cr * lr - ci * li); }
        v4u o; o.x = pk2(v[0], v[1]); o.y = pk2(v[2], v[3]); o.z = pk2(v[4], v[5]); o.w = pk2(v[6], v[7]); *(v4u*)(Fg + ((size_t)(((n >> 5) * 8 + (kc >> 1)) * 64) + (kc & 1) * 32 + (n & 31)) * 8) = o; }
    if (tid < 64) { float* l16 = (float*)(sl + SO_L16) + (size_t)(g * 64 + tid) * 2; l16[0] = lamp[2 * (tid * 17 + 16)]; l16[1] = lamp[2 * (tid * 17 + 16) + 1]; }
    __syncthreads();
}
__device__ __forceinline__ void rms_row_f32(const bf16* H, int m, const float* g, float* orow, int lane) {
    f32x4 v[16]; float s = 0.f;
#pragma unroll
    for (int j = 0; j < 16; ++j) { const v2u w = *(const v2u*)(H + ((size_t)(4 * j + (lane >> 4)) * M + m) * 64 + 4 * (lane & 15)); v[j] = (f32x4){bflo(w.x), bfhi(w.x), bflo(w.y), bfhi(w.y)}; s += (v[j].x * v[j].x + v[j].y * v[j].y) + (v[j].z * v[j].z + v[j].w * v[j].w); }
    const float rs = 1.0f / sqrtf(wave_sum(s) * (1.0f / DM) + RMS_EPS);
    const f32x4* gr = (const f32x4*)g + lane;
#pragma unroll
    for (int j = 0; j < 16; ++j) { const f32x4 gg = gr[64 * j]; ((f32x4*)orow + lane)[64 * j] = v[j] * rs * gg; }
}
__device__ __forceinline__ void prenorm_row(const float* xrow, bf16* H, unsigned char* H8, int m, pg8::ssq_t* ss, int lane) {
    const f32x4* xr = (const f32x4*)xrow + lane; float s = 0.f;
#pragma unroll
    for (int j = 0; j < 16; ++j) { const f32x4 v = xr[64 * j]; s += (v.x * v.x + v.y * v.y) + (v.z * v.z + v.w * v.w);
        v2u hw; hw.x = pk2(v.x, v.y); hw.y = pk2(v.z, v.w); *(v2u*)(H + ((size_t)(4 * j + (lane >> 4)) * M + m) * 64 + 4 * (lane & 15)) = hw;
        *(unsigned*)(H8 + pg8::tix8(m, 4 * lane + 256 * j)) = pg8::pk4_fp8(v.x * pg8::F8_ASCALE, v.y * pg8::F8_ASCALE, v.z * pg8::F8_ASCALE, v.w * pg8::F8_ASCALE); }
    s = wave_sum(s); if (lane == 0) *ss = pg8::ss_enc(s);
}
__device__ __forceinline__ void stagger(int bid, unsigned window_ns) {
    if (window_ns == 0u) return;
    const unsigned ticks = (((unsigned)bid * 89u) & 255u) * window_ns / 2560u;
    const unsigned long long t0 = __builtin_amdgcn_s_memrealtime();
    while ((unsigned)(__builtin_amdgcn_s_memrealtime() - t0) < ticks) __builtin_amdgcn_s_sleep(2);
}
__device__ __forceinline__ void swap_halves(unsigned& a, unsigned& b) { const auto r = __builtin_amdgcn_permlane32_swap(a, b, false, false); a = r[0]; b = r[1]; }
__device__ __forceinline__ float gelu_tanh(float x) { const float u = 0.7978845608028654f * (x + 0.044715f * x * x * x); const float t = 1.0f - 2.0f / (__expf(2.0f * u) + 1.0f); return 0.5f * x * (1.0f + t); }
__device__ __forceinline__ void attn_wave(const bf16* Q, const bf16* Kb, const bf16* VP, bf16* O, int b, int h, int q0, int lane) {
    const int r = lane & 31, hh = lane >> 5;
    const float scale = 0.08838834764831845f;
    const size_t bh = (size_t)(b * NH + h);
    const bf16* qfp = Q + ((bh * 64 + (q0 >> 5)) * 8 * 64 + lane) * 8;
    bf16x8 qf[8];
#pragma unroll
    for (int ks = 0; ks < 8; ++ks) qf[ks] = *(const bf16x8*)(qfp + ks * 512);
    f32x16 o[4];
#pragma unroll
    for (int d = 0; d < 4; ++d)
#pragma unroll
        for (int i = 0; i < 16; ++i) o[d][i] = 0.f;
    float R = 1.f;
    const bf16* kbase = Kb + (bh * 64 * 8 * 64 + lane) * 8;
    const bf16* vbase = VP + (bh * 64 * 8 * 64 + lane) * 8;
    const int ktd = q0 >> 5;
    bf16x8 kf[8];
    { const bf16* kp = kbase + (size_t)ktd * 4096;
#pragma unroll
      for (int ks = 0; ks < 8; ++ks) kf[ks] = *(const bf16x8*)(kp + ks * 512); }
#pragma unroll 1
    for (int kt = ktd; kt >= 0; --kt) {
        f32x16 s;
#pragma unroll
        for (int i = 0; i < 16; ++i) s[i] = 0.f;
#pragma unroll
        for (int ks = 0; ks < 8; ++ks) s = MFMA32(kf[ks], qf[ks], s);
        { const bf16* kp = kbase + (size_t)(kt > 0 ? kt - 1 : 0) * 4096;
#pragma unroll
          for (int ks = 0; ks < 8; ++ks) kf[ks] = *(const bf16x8*)(kp + ks * 512); }
        bf16x8 vf[2][4];
#pragma unroll
        for (int sx = 0; sx < 2; ++sx)
#pragma unroll
            for (int db = 0; db < 4; ++db) vf[sx][db] = *(const bf16x8*)(vbase + (size_t)((kt * 4 + db) * 2 + sx) * 512);
        const bool diag = (kt == ktd);
        float be[16], om[16];
#pragma unroll
        for (int i = 0; i < 16; ++i) { const float z = s[i], a = __builtin_amdgcn_exp2f(-fabsf(z) * (scale * 1.4426950408889634f)), t = __builtin_amdgcn_rcpf(1.0f + a), u = a * t;
            const bool valid = !diag || (crow(i, hh) < r); const bool pos = z >= 0.f;
            be[i] = valid ? (pos ? t : u) : 0.f; om[i] = valid ? (pos ? u : t) : 1.f; }
        float gp[4], pg[4], tot[4];
#pragma unroll
        for (int g = 0; g < 4; ++g) { gp[g] = (om[4 * g] * om[4 * g + 1]) * (om[4 * g + 2] * om[4 * g + 3]); pg[g] = __shfl_xor(gp[g], 32); tot[g] = gp[g] * pg[g]; }
        float T[4]; T[3] = 1.f; T[2] = tot[3]; T[1] = tot[3] * tot[2]; T[0] = T[1] * tot[1];
        float w[16];
#pragma unroll
        for (int g = 0; g < 4; ++g) { float run = R * T[g] * (hh == 0 ? pg[g] : 1.f);
#pragma unroll
            for (int i = 4 * g + 3; i >= 4 * g; --i) { w[i] = be[i] * run; run *= om[i]; } }
        R *= T[0] * tot[0];
#pragma unroll
        for (int sx = 0; sx < 2; ++sx) {
            v4u pw; pw.x = pk2(w[8 * sx], w[8 * sx + 1]); pw.y = pk2(w[8 * sx + 2], w[8 * sx + 3]); pw.z = pk2(w[8 * sx + 4], w[8 * sx + 5]); pw.w = pk2(w[8 * sx + 6], w[8 * sx + 7]);
            const bf16x8 wf = __builtin_bit_cast(bf16x8, pw);
#pragma unroll
            for (int db = 0; db < 4; ++db) o[db] = MFMA32(vf[sx][db], wf, o[db]);
        }
        if (__all(R < 1e-37f)) break;
    }
    const int orow_ = b * SEQ + q0 + r, ocol_ = h * HD + 4 * hh;
#pragma unroll
    for (int db = 0; db < 4; ++db)
#pragma unroll
        for (int q = 0; q < 4; q += 2) { v2u a, c; a.x = pk2(o[db][4 * q], o[db][4 * q + 1]); a.y = pk2(o[db][4 * q + 2], o[db][4 * q + 3]); c.x = pk2(o[db][4 * q + 4], o[db][4 * q + 5]); c.y = pk2(o[db][4 * q + 6], o[db][4 * q + 7]);
            unsigned ax = a.x, ay = a.y, cx = c.x, cy = c.y; swap_halves(ax, cx); swap_halves(ay, cy);
            v4u ov; ov.x = ax; ov.y = ay; ov.z = cx; ov.w = cy; *(v4u*)(O + pg8::tix(orow_, h * HD + 32 * db + 8 * (q + hh))) = ov; }
}
__device__ __forceinline__ void ssm_unit(int b, int g, const bf16* U, const bf16* Tg, const bf16* Eg, const bf16* Fg, const float* l16, const float* dsk, bf16* Y, unsigned char* Y8, LAS unsigned char* lds, int wave, int lane, int mode = 0  ) {
    LAS unsigned char* UL = lds;
    LAS unsigned char* LE16 = lds + 65536;
    LAS unsigned char* SP = lds + 98304;
    const int r = lane & 31, hh = lane >> 5, tid = wave * 64 + lane;
    const int nt3 = wave; const bf16* tb = Tg + ((size_t)(nt3 * 16) * 64 + lane) * 8; const bf16* fb = Fg + ((size_t)(nt3 * 8) * 64 + lane) * 8;
    bf16x8 tf[16], ff[8];
#pragma unroll
    for (int s = 0; s < 16; ++s) tf[s] = *(const bf16x8*)(tb + s * 512);
#pragma unroll
    for (int s2 = 0; s2 < 8; ++s2) ff[s2] = *(const bf16x8*)(fb + s2 * 512);
    { const v4u* ug = (const v4u*)(U + (size_t)(b * NG + g) * 4 * 16 * 64 * 8) + tid; v4u t[8];
#pragma unroll
      for (int i = 0; i < 8; ++i) t[i] = ug[512 * i];
#pragma unroll
      for (int i = 0; i < 8; ++i) *(LAS v4u*)(UL + (size_t)(tid + 512 * i) * 16) = t[i]; }
    __syncthreads();
    { const int mt = wave >> 1, nt0 = 2 * (wave & 1);
      f32x16 a0, a1;
#pragma unroll
      for (int i = 0; i < 16; ++i) { a0[i] = 0.f; a1[i] = 0.f; }
      const bf16* e0 = Eg + ((size_t)(nt0 * 16) * 64 + lane) * 8; const bf16* e1 = e0 + 16 * 512;
      const LAS unsigned char* ul = UL + ((size_t)(mt * 16) * 64 + lane) * 16;
#pragma unroll 8
      for (int s = 0; s < 16; ++s) { const bf16x8 uf = *(const LAS bf16x8*)(ul + s * 1024); const bf16x8 b0 = *(const bf16x8*)(e0 + s * 512), b1 = *(const bf16x8*)(e1 + s * 512);
          a0 = MFMA32(uf, b0, a0); a1 = MFMA32(uf, b1, a1); }
#pragma unroll
      for (int i = 0; i < 16; ++i) { LAS unsigned char* row = LE16 + (32 * mt + crow(i, hh)) * 256;
          *(LAS unsigned short*)(row + (32 * nt0 + r) * 2) = (unsigned short)(pk2(a0[i], 0.f) & 0xffffu); *(LAS unsigned short*)(row + (32 * nt0 + 32 + r) * 2) = (unsigned short)(pk2(a1[i], 0.f) & 0xffffu); } }
    __syncthreads();
    if (wave == 0 && mode < 2) { const int p = lane; const float lr = l16[2 * p], li = l16[2 * p + 1]; float sr = 0.f, si = 0.f;
#pragma unroll 1
        for (int k0 = 0; k0 < 128; k0 += 8) { unsigned le[8];
#pragma unroll
            for (int j = 0; j < 8; ++j) le[j] = *(const LAS unsigned*)(LE16 + (k0 + j) * 256 + 4 * p);
#pragma unroll
            for (int j = 0; j < 8; ++j) { *(LAS unsigned*)(SP + (k0 + j) * 272 + 4 * p) = pk2(sr, si);
                const float nr = lr * sr - li * si + bflo(le[j]), ni = lr * si + li * sr + bfhi(le[j]); sr = nr; si = ni; } } }
    __syncthreads();
    { const int nt = nt3;
      f32x4 dk[4];
#pragma unroll
      for (int q = 0; q < 4; ++q) dk[q] = *(const f32x4*)(dsk + 16 * g + 8 * (q & 1) + 4 * hh);
#pragma unroll 1
        for (int mt = 0; mt < 4; ++mt) { const int chunk = 32 * mt + r; const LAS unsigned char* ul = UL + ((size_t)(mt * 16) * 64 + lane) * 16;
            f32x16 acc;
#pragma unroll
            for (int i = 0; i < 16; ++i) acc[i] = 0.f;
#pragma unroll
            for (int s = 0; s < 16; ++s) { const bf16x8 bfr = *(const LAS bf16x8*)(ul + s * 1024); acc = MFMA32(tf[s], bfr, acc); }
#pragma unroll
            for (int s2 = 0; s2 < 8; ++s2) { const bf16x8 bfr = *(const LAS bf16x8*)(SP + chunk * 272 + 32 * s2 + 16 * hh); acc = MFMA32(ff[s2], bfr, acc); }
#pragma unroll
            for (int tq = 0; tq < 2; ++tq) { const int itok = 2 * nt + tq; unsigned ovx[2], ovy[2], o8[2];
#pragma unroll
                for (int e = 0; e < 2; ++e) { const int q = 2 * tq + e;
                    const v2u uw = *(const LAS v2u*)(UL + ((size_t)((mt * 16 + itok) * 64 + e * 32 + r)) * 16 + 8 * hh);
                    const float y0 = gelu_tanh(acc[4 * q] + dk[q].x * bflo(uw.x)), y1 = gelu_tanh(acc[4 * q + 1] + dk[q].y * bfhi(uw.x)), y2 = gelu_tanh(acc[4 * q + 2] + dk[q].z * bflo(uw.y)), y3 = gelu_tanh(acc[4 * q + 3] + dk[q].w * bfhi(uw.y));
                    ovx[e] = pk2(y0, y1); ovy[e] = pk2(y2, y3); o8[e] = pg8::pk4_fp8(y0 * pg8::F8_ASCALE, y1 * pg8::F8_ASCALE, y2 * pg8::F8_ASCALE, y3 * pg8::F8_ASCALE); }
                swap_halves(ovx[0], ovx[1]); swap_halves(ovy[0], ovy[1]); swap_halves(o8[0], o8[1]);
                v4u yo; yo.x = ovx[0]; yo.y = ovy[0]; yo.z = ovx[1]; yo.w = ovy[1]; v2u y8; y8.x = o8[0]; y8.y = o8[1];
                if (mode == 0) { *(v4u*)(Y + pg8::tix(b * SEQ + 16 * chunk + itok, 16 * g + 8 * hh)) = yo; *(v2u*)(Y8 + pg8::tix8(b * SEQ + 16 * chunk + itok, 16 * g + 8 * hh)) = y8; }
                else asm volatile("" :: "v"(yo.x), "v"(yo.y), "v"(yo.z), "v"(yo.w), "v"(y8.x), "v"(y8.y)); } } }
    __syncthreads();
}
#ifndef GEMM_ALIGN
#define GEMM_ALIGN true
#endif
#ifndef GEMM_SP2
#define GEMM_SP2 true
#endif
typedef __attribute__((address_space(4))) const Args* KArgP;
__device__ __forceinline__ KArgP kargs() { unsigned long long p = (unsigned long long)__builtin_amdgcn_kernarg_segment_ptr(); asm volatile("" : "+s"(p)); return (KArgP)p; }
#ifndef PH_MASK
#if defined(PROBE_NOMIX)
#define PH_MASK (0xFFFF & ~0x78)
#else
#define PH_MASK 0xFFFF
#endif
#endif
#define ON(i) (((PH_MASK) >> (i)) & 1)
#ifndef REP_P0
#define REP_P0 1
#endif
#ifndef REP_NORM
#define REP_NORM 1
#endif
#ifndef REP_IN
#define REP_IN 1
#endif
#ifndef REP_ATT
#define REP_ATT 1
#endif
#ifndef REP_SSM
#define REP_SSM 1
#endif
#ifndef SSM_PROBE_MODE
#define SSM_PROBE_MODE 0
#endif
#ifndef REP_FF1
#define REP_FF1 1
#endif
#ifndef REP_GB
#define REP_GB 1
#endif
#ifndef STAGGER_IN_NS
#define STAGGER_IN_NS 0u
#endif
#ifndef STAGGER_FF1_NS
#define STAGGER_FF1_NS 0u
#endif
#ifndef PROBE_SKEW_XCD
#define PROBE_SKEW_XCD -1
#endif
#ifndef PROBE_SKEW_LASTX
#define PROBE_SKEW_LASTX -1
#endif
#ifndef PROBE_SKEW_MASK
#define PROBE_SKEW_MASK 0xffffffffu
#endif
#if defined(PROBE_SKEW)
#define PROBE_SKEW_STAMP(k) do { if (b_.t0 && (PROBE_SKEW_XCD < 0 || (int)b_.x == PROBE_SKEW_XCD)) { const unsigned long long t_ = __builtin_amdgcn_s_memrealtime(); unsigned long long* pk_ = (unsigned long long*)(A_->ws + WS_CTL + 131072); atomicMax(pk_ + 2 * (k), ~t_); if (PROBE_SKEW_LASTX < 0 || (int)b_.x == PROBE_SKEW_LASTX) atomicMax(pk_ + 2 * (k) + 1, t_); } } while (0)
#else
#define PROBE_SKEW_STAMP(k) do { } while (0)
#endif
#ifndef FF2_ORDER
#define FF2_ORDER HalfMOrder
#endif
#ifndef PROBE_SEAMX
#define PROBE_SEAMX 1
#endif
#ifndef REP_P1
#define REP_P1 1
#endif
#ifndef REP_PE
#define REP_PE 1
#endif
#ifndef REP_BRS
#define REP_BRS 1
#endif
__global__ void __launch_bounds__(NWAVES * 64, 2) fwd(Args args_unused) {
    extern __shared__ __attribute__((aligned(16))) unsigned char lds_raw[];
    LAS unsigned char* lds = (LAS unsigned char*)lds_raw;
    volatile LAS unsigned* MISC = (volatile LAS unsigned*)(lds + MISC_OFF);
    const int wave_s = __builtin_amdgcn_readfirstlane(threadIdx.x >> 6);
    if (threadIdx.x < 64) MISC[threadIdx.x] = 0u;
    __syncthreads();
    int lo, hi;
    { KArgP A = kargs(); lo = A->ph_lo; hi = A->ph_hi;
      if (hi - lo > 1) (void)xcd_barrier_post((unsigned*)(A->ws + WS_CTL) + CW_BAR, MISC + 8); }
#define IN(k) (lo <= (k) && (k) < hi)
#define SEAM(k) do { if (IN(k) && IN((k) + 1)) { KArgP A_ = kargs(); XcdBarrier b_; b_.bar = (unsigned*)(A_->ws + WS_CTL) + CW_BAR; b_.x = xb_xcc_id(); b_.st = MISC + 8; b_.t0 = (wave_s == 0) && (pg8::lane_id() == 0); PROBE_SKEW_STAMP(k); for (int sx_ = 0; sx_ < PROBE_SEAMX; ++sx_) xcd_barrier(b_); } } while (0)
#define GWS int lane = pg8::lane_id(); asm volatile("" : "+v"(lane)); const int wave = wave_s, tid = wave * 64 + lane; (void)tid; \
    const int G = gridDim.x, bid = blockIdx.x, gw = bid * NWAVES + wave, NGW = G * NWAVES; (void)gw; (void)NGW; (void)bid; (void)G

    for (int rep_ = 0; rep_ < REP_P0; ++rep_) if (ON(0) && IN(0)) { KArgP A = kargs(); unsigned char* ws = A->ws; GWS; __syncthreads();
        LAS float* scr = (LAS float*)(lds + wave * 16640);
        tr_all_dyn(A, (unsigned*)(ws + WS_CTL + 196608), MISC + 16, wave, scr, lane);
        { const float* P = A->in[I_P]; bf16* PB = (bf16*)(ws + WS_PB);
          for (int c = gw * 64 + lane; c < DEPTH * M * PLE / 8; c += NGW * 64) { const f32x4 a = *(const f32x4*)(P + (size_t)c * 8), b2 = *(const f32x4*)(P + (size_t)c * 8 + 4);
              v4u o; o.x = pk2(a.x, a.y); o.y = pk2(a.z, a.w); o.z = pk2(b2.x, b2.y); o.w = pk2(b2.z, b2.w);
              const int e_ = c * 8, L_ = e_ / (M * PLE), m_ = (e_ / PLE) % M, col_ = e_ % PLE; *(v4u*)(PB + (size_t)L_ * M * PLE + ((size_t)(col_ >> 6) * M + m_) * 64 + (col_ & 63)) = o; } }
#if defined(PROBE_STREAMCAST)
        {
            const int idx[9] = {I_WIN, I_WBRA, I_WGLU, I_WBRS, I_WO, I_WFF1, I_WFF2, I_WPG, I_WPLE};
            const size_t cnt[9] = {(size_t)DEPTH * DM * INW, (size_t)DEPTH * AW * DM, (size_t)DEPTH * SW * SW, (size_t)DEPTH * SW * DM, (size_t)DEPTH * DM * DM, (size_t)DEPTH * DM * DFF, (size_t)DEPTH * DFF * DM, (size_t)DEPTH * DM * DM, (size_t)DEPTH * PLE * DM};
            bf16* dead = (bf16*)(ws + WS_ACT); size_t wpos = 0;
#pragma unroll
            for (int q = 0; q < 9; ++q) { const float* src = A->in[idx[q]]; const size_t n8 = cnt[q] / 8;
                for (size_t c = (size_t)gw * 64 + lane; c < n8; c += (size_t)NGW * 64) { const f32x4 a = __builtin_nontemporal_load((const f32x4*)(src + c * 8)), b2 = __builtin_nontemporal_load((const f32x4*)(src + c * 8 + 4));
                    v4u o; o.x = pk2(a.x, a.y); o.y = pk2(a.z, a.w); o.z = pk2(b2.x, b2.y); o.w = pk2(b2.z, b2.w); __builtin_nontemporal_store(o, (v4u*)(dead + ((wpos + c * 8) % ((size_t)200 << 20)))); }
                wpos += cnt[q]; } }
#endif
        __syncthreads();
        for (int it = bid; it < DEPTH * NG; it += G) ssm_prep(A, it / NG, it % NG, lds, tid);
    }
    SEAM(0);
    for (int rep_ = 0; rep_ < REP_P1; ++rep_) if (ON(1) && IN(1)) {
        { KArgP A = kargs(); unsigned char* ws = A->ws; GWS; const float* x = A->in[I_X]; bf16* Hb = (bf16*)(ws + WS_H); pg8::ssq_t* ss = (pg8::ssq_t*)(ws + WS_CTL + CTL_SS);
          for (int m = gw; m < M; m += NGW) prenorm_row(x + (size_t)m * DM, Hb, ws + WS_H8, m, ss + m, lane); }
#pragma unroll 1
        for (int L = 0; L < DEPTH * REP_PE; ++L) { KArgP A = kargs(); unsigned char* ws = A->ws; GWS;
            pg8::Gemm g{(const bf16*)(ws + WS_PB) + (size_t)(L % DEPTH) * M * PLE, (const bf16*)(ws + WS_W + (size_t)(L % DEPTH) * W_LAYER + WO_PLE), M, DM, PLE};
            pg8::StaticOrder S; S.init(M, DM, G, bid);
            pg8::EpiB<0, false, false> E{(bf16*)(ws + WS_PE) + (size_t)(L % DEPTH) * M * DM, nullptr, nullptr, DM, nullptr, lds + 131072};
            pg8::gemm_phase<pg8::EpiB<0, false, false>, pg8::StaticOrder, GEMM_ALIGN, GEMM_SP2>(lds, g, S, E, wave);
        }
    }
    SEAM(1);
#pragma unroll 1
    for (int L = 0; L < DEPTH; ++L) {
        const int pb = 2 + PH_PER_LAYER * L;
#define LAYER_PTRS KArgP A = kargs(); unsigned char* ws = A->ws; GWS; unsigned char* wl = ws + WS_W + (size_t)L * W_LAYER; (void)wl; \
        unsigned char* H8c = ws + WS_H8 + (size_t)(L & 1) * M * DM; unsigned char* H8n = ws + WS_H8 + (size_t)((L & 1) ^ 1) * M * DM; (void)H8c; (void)H8n; \
        bf16* Hc = (bf16*)(ws + WS_H) + (size_t)(L & 1) * M * DM; bf16* Hn = (bf16*)(ws + WS_H) + (size_t)((L & 1) ^ 1) * M * DM; (void)Hc; (void)Hn;     \
        pg8::ssq_t* SSq = (pg8::ssq_t*)(ws + WS_CTL + CTL_SS); (void)SSq
        for (int rep_ = 0; rep_ < REP_IN; ++rep_) if (ON(3) && IN(pb + 0)) { LAYER_PTRS; stagger(bid, STAGGER_IN_NS);
            { pg8::Gemm g{Hc, (const bf16*)(wl + WO_IN), M, INW / 2, DM}; QkvuOrder S; S.init(M, INW / 2, G, bid);
              pg8::EpiIn E{SSq + (0 * 2 + L) * M, lds + 131072, (bf16*)(ws + WS_ACT)};
              pg8::gemm_phase<pg8::EpiIn, QkvuOrder, GEMM_ALIGN, GEMM_SP2>(lds, g, S, E, wave); }
            { pg8::Gemm g{(const bf16*)H8c, (const bf16*)(wl + WO_IN + (64u << 20)), M, INW / 2, DM / 2}; RotOrder S; S.init(M, INW / 2, G, bid);
              pg8::EpiGates E{SSq + (0 * 2 + L) * M, ws + WS_ACT + AO_SA, lds + 131072};
              pg8::gemm_phase<pg8::EpiGates, RotOrder, GEMM_ALIGN, GEMM_SP2>(lds, g, S, E, wave); }
        }
        SEAM(pb + 0);
        if (ON(4) && IN(pb + 1)) { LAYER_PTRS;
            { const bf16* Qb = (const bf16*)(ws + WS_ACT + AO_Q); const bf16* Kb = (const bf16*)(ws + WS_ACT + AO_K); const bf16* VPb = (const bf16*)(ws + WS_ACT + AO_VP); bf16* ATT = (bf16*)(ws + WS_ACT + AO_ATT);
              for (int rep_ = 0; rep_ < REP_ATT; ++rep_) for (int pu = bid; pu < BATCH * NH * 4; pu += G) { const int bh = pu >> 2, qp = pu & 3, b = bh >> 4, h = bh & 15;
                  attn_wave(Qb, Kb, VPb, ATT, b, h, 256 * (7 - qp) + 32 * wave, lane);
                  attn_wave(Qb, Kb, VPb, ATT, b, h, 256 * qp + 32 * wave, lane); } }
            __syncthreads();
            { unsigned char* sl = ws + WS_SSM + (size_t)L * SSM_LAYER; const float* dsk = A->in[I_DSKIP] + L * SW;
              for (int rep_ = 0; rep_ < REP_SSM; ++rep_) for (int su = bid; su < BATCH * NG; su += G) { const int b = su >> 7, g = su & 127;
                  ssm_unit(b, g, (const bf16*)(ws + WS_ACT + AO_U), (const bf16*)(sl + SO_T) + (size_t)g * 65536, (const bf16*)(sl + SO_E) + (size_t)g * 32768, (const bf16*)(sl + SO_F) + (size_t)g * 32768,
                           (const float*)(sl + SO_L16) + g * 128, dsk, (bf16*)(ws + WS_ACT + AO_Y), ws + WS_Y8, lds, wave, lane, rep_ == 0 ? 0 : SSM_PROBE_MODE); } }
        }
        SEAM(pb + 1);
        for (int rep_ = 0; rep_ < REP_GB; ++rep_) if (ON(5) && IN(pb + 2)) {
            { LAYER_PTRS; pg8::Gemm g{(const bf16*)(ws + WS_Y8), (const bf16*)(wl + WO_GLU), M, SW, SW / 2}; pg8::StaticOrder S; S.init(M, SW, G, bid);
              pg8::EpiB<2, true, true, true> E{(bf16*)(ws + WS_ACT + AO_SSM), (const bf16*)(ws + WS_ACT + AO_Y), nullptr, SW, nullptr, lds + 131072};
              pg8::gemm_phase<pg8::EpiB<2, true, true, true>, pg8::StaticOrder, GEMM_ALIGN, GEMM_SP2>(lds, g, S, E, wave); }
            { LAYER_PTRS; pg8::Gemm g{(const bf16*)(ws + WS_ACT + AO_ATT), (const bf16*)(wl + WO_BRA), M, DM, AW}; RotOrder S; S.init(M, DM, G, bid);
              pg8::EpiB<3, false, false> E{(bf16*)(ws + WS_ACT + AO_TMP), (const bf16*)(ws + WS_ACT + AO_SA), nullptr, DM, nullptr, lds + 131072};
              pg8::gemm_phase<pg8::EpiB<3, false, false>, RotOrder, GEMM_ALIGN, GEMM_SP2>(lds, g, S, E, wave); }
        }
        SEAM(pb + 2);
        for (int rep_ = 0; rep_ < REP_BRS; ++rep_) if (ON(6) && IN(pb + 3)) { LAYER_PTRS;
            pg8::Gemm g{(const bf16*)(ws + WS_ACT + AO_SSM), (const bf16*)(wl + WO_BRS), M, DM, SW}; RotOrder S; S.init(M, DM, G, bid);
            pg8::EpiB<4, true, false> E{(bf16*)(ws + WS_ACT + AO_MRG), (const bf16*)(ws + WS_ACT + AO_TMP), (const bf16*)(ws + WS_ACT + AO_SS), DM, nullptr, lds + 131072};
            pg8::gemm_phase<pg8::EpiB<4, true, false>, RotOrder, GEMM_ALIGN, GEMM_SP2>(lds, g, S, E, wave);
        }
        SEAM(pb + 3);
        if (ON(7) && IN(pb + 4)) { LAYER_PTRS;
            pg8::Gemm g{(const bf16*)(ws + WS_ACT + AO_MRG), (const bf16*)(wl + WO_O), M, DM, DM}; RotOrder S; S.init(M, DM, G, bid);
            pg8::EpiRes<false> E{Hc, Hc, nullptr, nullptr, SSq + (1 * 2 + L) * M, 1, nullptr, lds + 131072};
            pg8::gemm_phase<pg8::EpiRes<false>, RotOrder, GEMM_ALIGN, GEMM_SP2>(lds, g, S, E, wave);
        }
        SEAM(pb + 4);
        for (int rep_ = 0; rep_ < REP_FF1; ++rep_) if (ON(9) && IN(pb + 5)) { LAYER_PTRS; stagger(bid, STAGGER_FF1_NS);
            pg8::Gemm g{Hc, (const bf16*)(wl + WO_FF1), M, DFF, DM}; RotOrder S; S.init(M, DFF, G, bid);
            pg8::EpiB<1, true, false> E{(bf16*)(ws + WS_MID), nullptr, nullptr, DFF, SSq + (1 * 2 + L) * M, lds + 131072};
#if defined(PROBE_SPLIT_FF1)
            S.iend = 4;
            pg8::gemm_phase<pg8::EpiB<1, true, false>, RotOrder, GEMM_ALIGN, GEMM_SP2>(lds, g, S, E, wave);
            { KArgP A_ = kargs(); XcdBarrier b_; b_.bar = (unsigned*)(A_->ws + WS_CTL) + CW_BAR; b_.x = xb_xcc_id(); b_.st = MISC + 8; b_.t0 = (wave_s == 0) && (pg8::lane_id() == 0); xcd_barrier(b_); }
            S.ibeg = 4; S.iend = 8;
#endif
            pg8::gemm_phase<pg8::EpiB<1, true, false>, RotOrder, GEMM_ALIGN, GEMM_SP2>(lds, g, S, E, wave);
        }
        SEAM(pb + 5);
#if defined(PROBE_FF2X)
        if (ON(10) && IN(pb + 6)) { LAYER_PTRS;
            pg8::Gemm g{(const bf16*)(ws + WS_MID), (const bf16*)(wl + WO_FF2), M, DM, DFF}; pg8::StaticOrder S; S.init(M, DM, G, bid);
            pg8::EpiB<0, false, false> E{(bf16*)(ws + WS_ACT + AO_TMP), nullptr, nullptr, DM, nullptr, lds + 131072};
            pg8::gemm_phase<pg8::EpiB<0, false, false>, pg8::StaticOrder, GEMM_ALIGN, GEMM_SP2>(lds, g, S, E, wave); }
#endif
#if defined(PROBE_L2X)
        if (ON(10) && IN(pb + 6)) { LAYER_PTRS;
            pg8::Gemm g{Hc, (const bf16*)(wl + WO_O), M, DM, -DM}; pg8::StaticOrder S; S.init(M, DM, G, bid);
            pg8::EpiB<0, false, false> E{(bf16*)(ws + WS_ACT + AO_TMP), nullptr, nullptr, DM, nullptr, lds + 131072};
            pg8::gemm_phase<pg8::EpiB<0, false, false>, pg8::StaticOrder, GEMM_ALIGN, GEMM_SP2>(lds, g, S, E, wave); }
#endif
#if defined(PROBE_OX)
        if (ON(10) && IN(pb + 6)) { LAYER_PTRS;
            pg8::Gemm g{Hc, (const bf16*)(wl + WO_O), M, DM, DM}; pg8::StaticOrder S; S.init(M, DM, G, bid);
            pg8::EpiB<0, false, false> E{(bf16*)(ws + WS_ACT + AO_TMP), nullptr, nullptr, DM, nullptr, lds + 131072};
            pg8::gemm_phase<pg8::EpiB<0, false, false>, pg8::StaticOrder, GEMM_ALIGN, GEMM_SP2>(lds, g, S, E, wave); }
#endif
        if (ON(10) && IN(pb + 6)) { LAYER_PTRS;
            pg8::Gemm g{(const bf16*)(ws + WS_MID), (const bf16*)(wl + WO_FF2), M, DM, DFF}; FF2_ORDER S; S.init(M, DM, G, bid);
            pg8::EpiRes<false> E{Hc, Hc, nullptr, nullptr, SSq + (2 * 2 + L) * M, 1, H8c, lds + 131072};
            pg8::gemm_phase<pg8::EpiRes<false>, FF2_ORDER, GEMM_ALIGN, GEMM_SP2>(lds, g, S, E, wave);
        }
        SEAM(pb + 6);
        if (ON(12) && IN(pb + 7)) { LAYER_PTRS; const int Ln = (L + 1 < DEPTH) ? L + 1 : L;
            pg8::Gemm g{(const bf16*)H8c, (const bf16*)(wl + WO_PG), M, DM, DM / 2};     RotOrder S; S.init(M, DM, G, bid);
            pg8::EpiRes<true> E{Hc, Hn, (const bf16*)(ws + WS_PE) + (size_t)L * M * DM, SSq + (2 * 2 + L) * M, SSq + (0 * 2 + Ln) * M, (L + 1 < DEPTH) ? 1 : 0, (L + 1 < DEPTH) ? H8n : nullptr, lds + 131072};
            pg8::gemm_phase<pg8::EpiRes<true>, RotOrder, GEMM_ALIGN, GEMM_SP2>(lds, g, S, E, wave);
        }
        SEAM(pb + 7);
    }
    if (ON(13) && IN(N_PHASES - 1)) { KArgP A = kargs(); unsigned char* ws = A->ws; GWS; const bf16* H = (const bf16*)(ws + WS_H) + (size_t)(DEPTH & 1) * M * DM; const float* gf = A->in[I_GFIN]; float* out = A->out;
        for (int m = gw; m < M; m += NGW) rms_row_f32(H, m, gf, out + (size_t)m * DM, lane); }
#if defined(PROBE_SKEW)
    { KArgP A_ = kargs(); XcdBarrier b_; b_.bar = (unsigned*)(A_->ws + WS_CTL) + CW_BAR; b_.x = xb_xcc_id(); b_.st = MISC + 8; b_.t0 = (wave_s == 0) && (pg8::lane_id() == 0); if (A_->ph_hi - A_->ph_lo > 1) { PROBE_SKEW_STAMP(N_PHASES - 1); xcd_barrier(b_); } }
    { KArgP A = kargs(); if (blockIdx.x == 0 && wave_s == 0 && pg8::lane_id() == 0 && A->ph_hi - A->ph_lo > 1) { unsigned long long* pk = (unsigned long long*)(A->ws + WS_CTL + 131072); unsigned long long tot = 0;
        for (int s_ = 0; s_ < N_PHASES; ++s_) { const unsigned long long fn = __hip_atomic_load(pk + 2 * s_, __ATOMIC_RELAXED, __HIP_MEMORY_SCOPE_AGENT), l_ = __hip_atomic_load(pk + 2 * s_ + 1, __ATOMIC_RELAXED, __HIP_MEMORY_SCOPE_AGENT); if (l_ != 0ull && ((PROBE_SKEW_MASK >> s_) & 1)) tot += l_ - ~fn; }
        const unsigned long long t0 = __builtin_amdgcn_s_memrealtime(); while (__builtin_amdgcn_s_memrealtime() - t0 < tot * PROBE_SKEW) __builtin_amdgcn_s_sleep(8); } }
#endif
#undef IN
#undef SEAM
}

extern "C" void kernel_launch(void* const* d_in, const int* in_sizes, int n_in, void* d_out, int out_size, void* d_ws, size_t ws_size, hipStream_t stream) {
    static int grid = 0;
    if (grid == 0) {
        if (n_in != 23 || in_sizes[0] != M * DM || out_size != M * DM || ws_size < WS_END) { fprintf(stderr, "kernel_launch: unexpected shapes / workspace (n_in %d, ws %zu, need %zu); nothing launched\n", n_in, ws_size, (size_t)WS_END); grid = -1; return; }
        int dev = 0, cus = 0, per_cu = 0;
        if (hipGetDevice(&dev) != hipSuccess || hipDeviceGetAttribute(&cus, hipDeviceAttributeMultiprocessorCount, dev) != hipSuccess) { grid = -1; return; }
        if (hipFuncSetAttribute((const void*)fwd, hipFuncAttributeMaxDynamicSharedMemorySize, LDS_BYTES) != hipSuccess) { fprintf(stderr, "kernel_launch: hipFuncSetAttribute failed\n"); grid = -1; return; }
        if (hipOccupancyMaxActiveBlocksPerMultiprocessor(&per_cu, (const void*)fwd, NWAVES * 64, LDS_BYTES) != hipSuccess || per_cu < 1) fprintf(stderr, "kernel_launch: note: occupancy query says %d workgroups per CU\n", per_cu);
        (void)hipGetLastError();
        grid = cus;
    }
    if (grid < 0) return;
    if (hipMemsetAsync((char*)d_ws + WS_CTL, 0, CTL_ZERO_BYTES, stream) != hipSuccess) return;
    Args a{};
    for (int i = 0; i < 23; ++i) a.in[i] = (const float*)d_in[i];
    a.out = (float*)d_out; a.ws = (unsigned char*)d_ws;
#if MK_N_LAUNCHES == 1
    a.ph_lo = 0; a.ph_hi = N_PHASES; a.li = 0;
    hipLaunchKernelGGL(fwd, dim3(grid), dim3(NWAVES * 64), LDS_BYTES, stream, a);
#else
    for (int ph = 0; ph < N_PHASES; ++ph) { a.ph_lo = ph; a.ph_hi = ph + 1; a.li = ph;
        hipLaunchKernelGGL(fwd, dim3(grid), dim3(NWAVES * 64), LDS_BYTES, stream, a); }
#endif
}
```

```cpp
#include <hip/hip_runtime.h>
#include <cstdio>
#include <cstdint>
namespace pg8 {
#define PG8_LAS __attribute__((address_space(3)))
typedef unsigned short bf16_t;
typedef short bf16x8 __attribute__((ext_vector_type(8)));
typedef float f32x4 __attribute__((ext_vector_type(4)));
typedef unsigned u32x4 __attribute__((ext_vector_type(4)));
typedef int i32x8 __attribute__((ext_vector_type(8)));
constexpr int BM = 256, BK = 64, HALF = 128, HTB = HALF * BK * 2  , STAGE_BYTES = 8 * HTB, NXCD = 8, WGM = 8;

__host__ __device__ __forceinline__ int lds_byte(int r, int c) { const int st = (r >> 4) * 2 + (c >> 5), rr = r & 15, cc = c & 31, ob = rr * 64 + cc * 2; return st * 1024 + (ob ^ (((ob >> 9) & 1) << 5)); }
__host__ __device__ __forceinline__ void stage_rc(int b, int& R, int& C) { const int st = b / 1024, sb = b % 1024, swz = sb ^ (((sb >> 9) & 1) << 5); R = (st >> 1) * 16 + swz / 64; C = (st & 1) * 32 + (swz % 64) / 2; }
__host__ __device__ __forceinline__ int perm32(int rho) { const int n = rho >> 4, i = rho & 15; return 8 * (i >> 2) + 4 * n + (i & 3); }

__device__ __forceinline__ int lane_id() { unsigned z = 0u; asm volatile("" : "+v"(z)); return (int)__builtin_amdgcn_mbcnt_hi(~0u, __builtin_amdgcn_mbcnt_lo(~0u, z)); }
struct Unit { int pm, pn; };
struct Gemm { const bf16_t* A; const bf16_t* Bt; int M, N, K; };
__host__ __device__ __forceinline__ size_t tix(int row, int col) { return ((size_t)(col >> 6) * 8192 + row) * 64 + (col & 63); }

struct StaticOrder {
    int nM, nN, nwg, G, c, ibeg, iend;
    __host__ __device__ void init(int M, int N, int G_, int c_) { nM = M / BM; nN = N / BM; nwg = nM * nN; G = G_; c = c_; ibeg = 0; iend = 0x7fffffff; }
    __host__ __device__ bool next(int i, Unit& u) const {
        i += ibeg; if (i >= iend) return false;
        const long L = (long)i * G + c; if (L >= nwg) return false;
        int wgid = (int)L; { const int q = nwg / NXCD, r = nwg % NXCD, xcd = wgid % NXCD, off = wgid / NXCD; wgid = (xcd < r ? xcd * (q + 1) : r * (q + 1) + (xcd - r) * q) + off; }
        const int nig = WGM * nN, gid = wgid / nig, fm = gid * WGM, gsz = (nM - fm) < WGM ? (nM - fm) : WGM;
        u.pm = fm + ((wgid % nig) % gsz); u.pn = (wgid % nig) / gsz; return true;
    }
    __device__ __forceinline__ void a_ready(const Unit&) const {}
    __device__ __forceinline__ void done(const Unit&) const {}
};

typedef float f32x2c __attribute__((ext_vector_type(2)));
typedef __bf16 bf16x2c __attribute__((ext_vector_type(2)));
__device__ __forceinline__ unsigned cvt_pk_bf16(float lo, float hi) { const f32x2c v = {lo, hi}; return __builtin_bit_cast(unsigned, __builtin_convertvector(v, bf16x2c)); }
typedef float f32x2 __attribute__((ext_vector_type(2)));
typedef unsigned u32x2 __attribute__((ext_vector_type(2)));
__device__ __forceinline__ float bf_lo(unsigned w) { return __uint_as_float(w << 16); }
__device__ __forceinline__ float bf_hi(unsigned w) { return __uint_as_float(w & 0xffff0000u); }
typedef unsigned long long ssq_t;
__device__ __forceinline__ ssq_t ss_enc(float s) { return (ssq_t)(s * 16777216.0f); }
__device__ __forceinline__ float ss_dec(ssq_t v) { return (float)v * (1.0f / 16777216.0f); }
__device__ __forceinline__ unsigned q8(float s) { return (unsigned)(s * 255.0f + 0.5f); }
__device__ __forceinline__ unsigned pack4q(float a, float b, float c, float d) { return q8(a) | (q8(b) << 8) | (q8(c) << 16) | (q8(d) << 24); }
constexpr float F8_ASCALE = 8.0f, F8_WSCALE = 512.0f, F8_UNSCALE = 1.0f / 4096.0f;
__device__ __forceinline__ unsigned pk4_fp8(float a, float b, float c, float d) { unsigned w = 0u; w = __builtin_amdgcn_cvt_pk_fp8_f32(a, b, w, false); w = __builtin_amdgcn_cvt_pk_fp8_f32(c, d, w, true); return w; }
__host__ __device__ __forceinline__ size_t tix8(int row, int col) { return ((size_t)(col >> 7) * 8192 + row) * 128 + (col & 127); }
__device__ __forceinline__ float sigm(float x) { return __builtin_amdgcn_rcpf(1.0f + __expf(-x)); }

__device__ __forceinline__ int xp_pos(int r, int c) { return r * 64 + ((c + (r >> 2)) & 3) * 16; }
__device__ __forceinline__ int xp_pos8(int r, int c) { return r * 32 + ((c + (r >> 3)) & 3) * 8; }
__device__ __forceinline__ u32x4 xpose_ld(PG8_LAS unsigned char* tile, int fr, int fq, int ln, const u32x4 v) {
    *(PG8_LAS u32x4*)(tile + xp_pos(ln >> 2, ln & 3)) = v;
    return *(const PG8_LAS u32x4*)(tile + xp_pos(fr, fq));
}
__device__ __forceinline__ u32x4 xpose_st(PG8_LAS unsigned char* tile, int fr, int fq, int ln, const u32x4 w) {
    *(PG8_LAS u32x4*)(tile + xp_pos(fr, fq)) = w;
    return *(const PG8_LAS u32x4*)(tile + xp_pos(ln >> 2, ln & 3));
}
struct EpiIn {
    static constexpr bool PERM = true, AFTER_DRAIN = false, FP8 = false, IDEMP = false;
    const ssq_t* ssin;
    PG8_LAS unsigned char* vlds;
    bf16_t* ACT;
    __device__ __forceinline__ void operator()(const f32x4 (&acc)[2][2][4][2], const Unit& u, int wr, int wc, int fr, int fq) const {
        const int colt = u.pn * BM, row0 = u.pm * BM + wr * 64 + fr;
        const int b = (u.pm * BM) >> 11, s00 = ((u.pm * BM) & 2047) + wr * 64;
        float rr[2][4];
#pragma unroll
        for (int ai = 0; ai < 2; ++ai)
#pragma unroll
            for (int m = 0; m < 4; ++m) rr[ai][m] = __builtin_amdgcn_rsqf(ss_dec(ssin[row0 + ai * HALF + m * 16]) * (1.0f / 4096.0f) + 1e-6f);
        if (colt >= 4096 && colt < 6144) {
            const int h0 = (colt - 4096) >> 7; const int lane = fq * 16 + fr, rv = lane & 31, hv = lane >> 5;
            PG8_LAS unsigned char* vt = vlds + (wr * 4 + wc) * 2048;
#pragma unroll
            for (int ai = 0; ai < 2; ++ai)
#pragma unroll
                for (int m = 0; m < 4; ++m) { const int t = (s00 + ai * HALF + m * 16) >> 5, sx = m & 1;
#pragma unroll
                    for (int bj = 0; bj < 2; ++bj) { const f32x4 v0 = acc[ai][bj][m][0] * rr[ai][m], v1 = acc[ai][bj][m][1] * rr[ai][m];
                        u32x4 w; w.x = cvt_pk_bf16(v0[0], v0[1]); w.y = cvt_pk_bf16(v0[2], v0[3]); w.z = cvt_pk_bf16(v1[0], v1[1]); w.w = cvt_pk_bf16(v1[2], v1[3]);
                        PG8_LAS unsigned char* tb = vt + ((m * 2 + bj) & 1) * 1024;
                        *(PG8_LAS u32x4*)(tb + fr * 64 + fq * 16) = w;
                        unsigned short q[8];
#pragma unroll
                        for (int j = 0; j < 8; ++j) q[j] = *(const PG8_LAS unsigned short*)(tb + ((j & 3) + 4 * hv + 8 * (j >> 2)) * 64 + rv * 2);
                        u32x4 o; o.x = q[0] | ((unsigned)q[1] << 16); o.y = q[2] | ((unsigned)q[3] << 16); o.z = q[4] | ((unsigned)q[5] << 16); o.w = q[6] | ((unsigned)q[7] << 16);
                        *(u32x4*)(ACT + ((size_t)2 << 24) + ((((size_t)((b * 16 + h0 + bj) * 64 + t) * 4 + wc) * 2 + sx) * 64 + lane) * 8) = o; } }
        } else if (colt >= 6144) {
            const int g0 = ((colt - 6144) >> 4) + 2 * wc + (fq >> 1), hu = fq & 1;
#pragma unroll
            for (int ai = 0; ai < 2; ++ai)
#pragma unroll
                for (int m = 0; m < 4; ++m) { const int chunk = (s00 + ai * HALF + m * 16) >> 4, mt = chunk >> 5, ru = chunk & 31;
#pragma unroll
                    for (int bj = 0; bj < 2; ++bj) { const f32x4 v0 = acc[ai][bj][m][0] * rr[ai][m], v1 = acc[ai][bj][m][1] * rr[ai][m];
                        u32x4 w; w.x = cvt_pk_bf16(v0[0], v0[1]); w.y = cvt_pk_bf16(v0[2], v0[3]); w.z = cvt_pk_bf16(v1[0], v1[1]); w.w = cvt_pk_bf16(v1[2], v1[3]);
                        *(u32x4*)(ACT + ((size_t)3 << 24) + ((((size_t)((b * 128 + g0 + 8 * bj) * 4 + mt) * 16 + fr) * 64) + hu * 32 + ru) * 8) = w; } }
        } else {
            bf16_t* base = ACT + ((size_t)(colt >> 11) << 24); const int h0 = (colt & 2047) >> 7, hq = wc >> 1, ks = 4 * (wc & 1) + fq;
#pragma unroll
            for (int ai = 0; ai < 2; ++ai)
#pragma unroll
                for (int m = 0; m < 4; ++m) { const int t = (s00 + ai * HALF + m * 16) >> 5, rq = 16 * (m & 1) + fr;
#pragma unroll
                    for (int bj = 0; bj < 2; ++bj) { const f32x4 v0 = acc[ai][bj][m][0] * rr[ai][m], v1 = acc[ai][bj][m][1] * rr[ai][m];
                        u32x4 w; w.x = cvt_pk_bf16(v0[0], v0[1]); w.y = cvt_pk_bf16(v0[2], v0[3]); w.z = cvt_pk_bf16(v1[0], v1[1]); w.w = cvt_pk_bf16(v1[2], v1[3]);
                        *(u32x4*)(base + ((((size_t)((b * 16 + h0 + bj) * 64 + t) * 8 + ks) * 64) + hq * 32 + rq) * 8) = w; } }
        }
    }
};
struct EpiGates {
    static constexpr bool PERM = true, AFTER_DRAIN = false, FP8 = true, IDEMP = false;
    const ssq_t* ssin; unsigned char* SA8; PG8_LAS unsigned char* xl;
    __device__ __forceinline__ void operator()(const f32x4 (&acc)[2][2][4][2], const Unit& u, int wr, int wc, int fr, int fq) const {
        const int colt = u.pn * BM, row0 = u.pm * BM + wr * 64 + fr;
        unsigned char* base = SA8 + ((size_t)(colt >> 12) << 26); const int col0 = (colt & 4095) + wc * 32 + 8 * fq;
        float rs[2][4];
#pragma unroll
        for (int ai = 0; ai < 2; ++ai)
#pragma unroll
            for (int m = 0; m < 4; ++m) rs[ai][m] = ss_dec(ssin[row0 + ai * HALF + m * 16]);
#pragma unroll
        for (int ai = 0; ai < 2; ++ai)
#pragma unroll
            for (int m = 0; m < 4; ++m) { const int row = row0 + ai * HALF + m * 16; unsigned char* rowp = base + (size_t)row * 4096 + col0;
                const float rr = F8_UNSCALE * __builtin_amdgcn_rsqf(rs[ai][m] * (1.0f / 4096.0f) + 1e-6f);
#pragma unroll
                for (int bj = 0; bj < 2; ++bj) { const f32x4 v0 = acc[ai][bj][m][0] * rr, v1 = acc[ai][bj][m][1] * rr;
                    u32x2 w; w.x = pack4q(sigm(v0[0]), sigm(v0[1]), sigm(v0[2]), sigm(v0[3])); w.y = pack4q(sigm(v1[0]), sigm(v1[1]), sigm(v1[2]), sigm(v1[3]));
                    *(u32x2*)(rowp + bj * HALF) = w; } }
    }
};
template <int MODE, bool OT  , bool XT  , bool F8 = false  > struct EpiB {
    static constexpr bool PERM = true, AFTER_DRAIN = false, FP8 = F8, IDEMP = (MODE == 1);
    bf16_t* O; const bf16_t* X; const bf16_t* Y; int ldc; const ssq_t* ssin; PG8_LAS unsigned char* xl;
    __device__ __forceinline__ void operator()(const f32x4 (&acc)[2][2][4][2], const Unit& u, int wr, int wc, int fr, int fq) const { body<true>(acc, u, wr, wc, fr, fq); }
    template <bool ST> __device__ __forceinline__ void body(const f32x4 (&acc)[2][2][4][2], const Unit& u, int wr, int wc, int fr, int fq) const {
        const int row0 = u.pm * BM + wr * 64 + fr, col0 = u.pn * BM + wc * 32 + 8 * fq;
        float r2a[2][4];
        if (MODE == 1) {
#pragma unroll
            for (int ai = 0; ai < 2; ++ai)
#pragma unroll
                for (int m = 0; m < 4; ++m) r2a[ai][m] = ss_dec(ssin[row0 + ai * HALF + m * 16]); }
#pragma unroll
        for (int ai = 0; ai < 2; ++ai) {
            u32x4 xw[4][2], yw[4][2]; float r2[4];
#pragma unroll
            for (int m = 0; m < 4; ++m) { const size_t off = (size_t)(row0 + ai * HALF + m * 16) * ldc + col0;
                r2[m] = 1.f; if (MODE == 1) r2[m] = r2a[ai][m];
#pragma unroll
                for (int bj = 0; bj < 2; ++bj) {
                    if (MODE == 3) { const u32x2 g8 = *(const u32x2*)((const unsigned char*)X + off + bj * HALF); xw[m][bj] = (u32x4){g8.x, g8.y, 0u, 0u}; }
                    else if (MODE >= 2) xw[m][bj] = *(const u32x4*)(X + (XT ? tix(row0 + ai * HALF + m * 16, col0 + bj * HALF) : off + bj * HALF));
                    if (MODE == 4) { const u32x2 g8 = *(const u32x2*)((const unsigned char*)Y + off + bj * HALF); yw[m][bj] = (u32x4){g8.x, g8.y, 0u, 0u}; } } }
#pragma unroll
            for (int m = 0; m < 4; ++m) { const size_t off = (size_t)(row0 + ai * HALF + m * 16) * ldc + col0;
                if (MODE == 1) r2[m] = __builtin_amdgcn_rcpf(r2[m] * (1.0f / 4096.0f) + 1e-6f);
#pragma unroll
                for (int bj = 0; bj < 2; ++bj) { float v[8];
#pragma unroll
                    for (int j = 0; j < 4; ++j) { v[j] = acc[ai][bj][m][0][j]; v[4 + j] = acc[ai][bj][m][1][j]; }
                    if (MODE == 1) {
#pragma unroll
                        for (int j = 0; j < 8; ++j) { const float t = fmaxf(v[j], 0.f); v[j] = t * t * r2[m]; } }
                    if (MODE >= 2) { const u32x4 xq = xw[m][bj]; float x[8];
                        if (MODE == 3) {
#pragma unroll
                            for (int j = 0; j < 4; ++j) { x[j] = (float)((xq.x >> (8 * j)) & 0xffu) * (1.0f / 255.0f); x[4 + j] = (float)((xq.y >> (8 * j)) & 0xffu) * (1.0f / 255.0f); } }
                        else { x[0] = bf_lo(xq.x); x[1] = bf_hi(xq.x); x[2] = bf_lo(xq.y); x[3] = bf_hi(xq.y); x[4] = bf_lo(xq.z); x[5] = bf_hi(xq.z); x[6] = bf_lo(xq.w); x[7] = bf_hi(xq.w); }
                        if (MODE == 2) {
#pragma unroll
                            for (int j = 0; j < 8; ++j) v[j] = x[j] * sigm(F8 ? v[j] * F8_UNSCALE : v[j]); }
                        if (MODE == 3) {
#pragma unroll
                            for (int j = 0; j < 8; ++j) v[j] = x[j] * v[j]; }
                        if (MODE == 4) { const u32x4 yq = yw[m][bj]; float y[8];
#pragma unroll
                            for (int j = 0; j < 4; ++j) { y[j] = (float)((yq.x >> (8 * j)) & 0xffu) * (1.0f / 255.0f); y[4 + j] = (float)((yq.y >> (8 * j)) & 0xffu) * (1.0f / 255.0f); }
#pragma unroll
                            for (int j = 0; j < 8; ++j) v[j] = x[j] + y[j] * v[j]; } }
                    u32x4 w; w.x = cvt_pk_bf16(v[0], v[1]); w.y = cvt_pk_bf16(v[2], v[3]); w.z = cvt_pk_bf16(v[4], v[5]); w.w = cvt_pk_bf16(v[6], v[7]);
                    if (ST) { const int ln = fq * 16 + fr, rT = u.pm * BM + wr * 64 + ai * HALF + m * 16 + (ln >> 2), cT = u.pn * BM + wc * 32 + bj * HALF + 8 * (ln & 3);
                        const u32x4 wt = xpose_st(xl + (wr * 4 + wc) * 2048 + ((m * 2 + bj) & 1) * 1024, fr, fq, ln, w);
                        *(u32x4*)(O + (OT ? tix(rT, cT) : (size_t)rT * ldc + cT)) = wt; }
                    else asm volatile("" :: "v"(w.x), "v"(w.y), "v"(w.z), "v"(w.w)); } }
            asm volatile("" ::: "memory"); }
    }
};
template <bool GATE, bool H8 = true> struct EpiRes {
    static constexpr bool PERM = true, AFTER_DRAIN = false, FP8 = GATE, IDEMP = false;
#ifndef EPIRES_NB
#define EPIRES_NB 4
#endif
#ifndef EPIRES_NBG
#define EPIRES_NBG 2
#endif
    static constexpr int NB = GATE ? EPIRES_NBG : EPIRES_NB;
    const bf16_t* base; bf16_t* out; const bf16_t* pe; const ssq_t* ssin; ssq_t* ssout; int nx; unsigned char* h8out; PG8_LAS unsigned char* xl;
    __device__ __forceinline__ void operator()(const f32x4 (&acc)[2][2][4][2], const Unit& u, int wr, int wc, int fr, int fq) const {
        const int row0 = u.pm * BM + wr * 64 + fr, col0 = u.pn * BM + wc * 32 + 8 * fq;
        const bool NEXT = nx != 0;
#pragma unroll
        for (int g0 = 0; g0 < 8; g0 += NB) {
            u32x4 bb[NB][2], pp[NB][2]; float rin[NB];
#pragma unroll
            for (int gi = 0; gi < NB; ++gi) { const int ai = (g0 + gi) >> 2, m = (g0 + gi) & 3, row = row0 + ai * HALF + m * 16; const size_t off = (size_t)row * 4096 + col0;
                rin[gi] = 1.f; if (GATE) rin[gi] = ss_dec(ssin[row]);
#pragma unroll
                for (int bj = 0; bj < 2; ++bj) { const int ln = fq * 16 + fr, rT = row - fr + (ln >> 2), cT = col0 - 8 * fq + bj * HALF + 8 * (ln & 3);
                    bb[gi][bj] = *(const u32x4*)(base + tix(rT, cT)); if (GATE) pp[gi][bj] = *(const u32x4*)(pe + (size_t)rT * 4096 + cT); } }
#pragma unroll
            for (int gi = 0; gi < NB; ++gi) { const int ai = (g0 + gi) >> 2, m = (g0 + gi) & 3, row = row0 + ai * HALF + m * 16;
                if (GATE) rin[gi] = F8_UNSCALE * __builtin_amdgcn_rsqf(rin[gi] * (1.0f / 4096.0f) + 1e-6f);
                float sq = 0.f;
#pragma unroll
                for (int bj = 0; bj < 2; ++bj) { f32x4 a0 = acc[ai][bj][m][0], a1 = acc[ai][bj][m][1];
                    PG8_LAS unsigned char* tl = xl + (wr * 4 + wc) * 2048 + (bj & 1) * 1024; const int ln = fq * 16 + fr;
                    if (GATE) { const u32x4 pw = xpose_ld(tl, fr, fq, ln, pp[gi][bj]); const float rr = rin[gi];
                        a0[0] = bf_lo(pw.x) * sigm(a0[0] * rr); a0[1] = bf_hi(pw.x) * sigm(a0[1] * rr); a0[2] = bf_lo(pw.y) * sigm(a0[2] * rr); a0[3] = bf_hi(pw.y) * sigm(a0[3] * rr);
                        a1[0] = bf_lo(pw.z) * sigm(a1[0] * rr); a1[1] = bf_hi(pw.z) * sigm(a1[1] * rr); a1[2] = bf_lo(pw.w) * sigm(a1[2] * rr); a1[3] = bf_hi(pw.w) * sigm(a1[3] * rr); }
                    const u32x4 bw = xpose_ld(tl, fr, fq, ln, bb[gi][bj]);
                    const f32x4 h0 = (f32x4){bf_lo(bw.x), bf_hi(bw.x), bf_lo(bw.y), bf_hi(bw.y)} + a0, h1 = (f32x4){bf_lo(bw.z), bf_hi(bw.z), bf_lo(bw.w), bf_hi(bw.w)} + a1;
                    u32x4 hw; hw.x = cvt_pk_bf16(h0[0], h0[1]); hw.y = cvt_pk_bf16(h0[2], h0[3]); hw.z = cvt_pk_bf16(h1[0], h1[1]); hw.w = cvt_pk_bf16(h1[2], h1[3]);
                    const int rT = row - fr + (ln >> 2), cT = col0 - 8 * fq + bj * HALF + 8 * (ln & 3);
                    *(u32x4*)(out + tix(rT, cT)) = xpose_st(tl, fr, fq, ln, hw);
                    if (H8 && h8out) { u32x2 q; q.x = pk4_fp8(h0[0] * F8_ASCALE, h0[1] * F8_ASCALE, h0[2] * F8_ASCALE, h0[3] * F8_ASCALE); q.y = pk4_fp8(h1[0] * F8_ASCALE, h1[1] * F8_ASCALE, h1[2] * F8_ASCALE, h1[3] * F8_ASCALE);
                        *(PG8_LAS u32x2*)(tl + xp_pos8(fr, fq)) = q;
                        *(u32x2*)(h8out + tix8(rT, cT)) = *(const PG8_LAS u32x2*)(tl + xp_pos8(ln >> 2, ln & 3)); }
                    if (NEXT) sq += (h0[0] * h0[0] + h0[1] * h0[1]) + (h0[2] * h0[2] + h0[3] * h0[3]) + (h1[0] * h1[0] + h1[1] * h1[1]) + (h1[2] * h1[2] + h1[3] * h1[3]); }
                if (NEXT) { sq += __shfl_xor(sq, 16); sq += __shfl_xor(sq, 32); if (fq == 0) atomicAdd(ssout + row, ss_enc(sq)); } }
            asm volatile("" ::: "memory"); }
    }
};
template <class Epi, class Sched, bool ALIGN_EPI = false, bool SP2 = false>
__device__ __forceinline__ void gemm_phase(PG8_LAS unsigned char* lds, const Gemm g, const Sched& S, const Epi& E, const int wid_in  ) {
    int lane_ = lane_id(); asm volatile("" : "+v"(lane_));
    const int wid = wid_in, lane = lane_, tid = wid * 64 + lane, wr = wid >> 2, wc = wid & 3, fr = lane & 15, fq = lane >> 4;
    const int K = g.K < 0 ? -g.K : g.K, nt = K / BK;
    unsigned voffA[2], voffB[2];
#pragma unroll
    for (int i = 0; i < 2; ++i) { int R, C; stage_rc(tid * 16 + i * 8192, R, C); const int Rb = Epi::PERM ? ((R & ~31) + perm32(R & 31)) : R;
        voffA[i] = (unsigned)(R * BK + C) * 2u; voffB[i] = (unsigned)(Rb * BK + C) * 2u; }
    const size_t kstepA = (size_t)g.M * BK * 2, kstepB = (size_t)g.N * BK * 2;
    const size_t hstep = (size_t)HALF * BK * 2;
    const size_t tstep = 2 * hstep;
    const unsigned ldsw = (unsigned)wid * 1024u;
    const int aoff = lds_byte(wr * 64 + fr, fq * 8), boff = lds_byte(wc * 32 + fr, fq * 8);
#define PG8_SA(b, h) (((b) * 2 + (h)) * HTB)
#define PG8_SB(b, h) ((4 + (b) * 2 + (h)) * HTB)
#define PG8_STAGE(bufoff, gbase, voff) do { _Pragma("unroll") for (int _i = 0; _i < 2; ++_i) \
        __builtin_amdgcn_global_load_lds((const unsigned*)((const char*)(gbase) + _i * 8192 + (voff)[0]), (PG8_LAS unsigned*)(lds + (bufoff) + ldsw + _i * 8192), 16, 0, 0); } while (0)
#define PG8_LDA(dst, b, h) do { _Pragma("unroll") for (int m = 0; m < 4; ++m) _Pragma("unroll") for (int k = 0; k < 2; ++k) dst[m][k] = *(const PG8_LAS bf16x8*)(lds + PG8_SA(b, h) + aoff + m * 2048 + k * 1024); } while (0)
#define PG8_LDB(dst, b, h) do { _Pragma("unroll") for (int n = 0; n < 2; ++n) _Pragma("unroll") for (int k = 0; k < 2; ++k) dst[n][k] = *(const PG8_LAS bf16x8*)(lds + PG8_SB(b, h) + boff + n * 2048 + k * 1024); } while (0)
#define PG8_CAT(x, y) __builtin_bit_cast(i32x8, __builtin_shufflevector((x), (y), 0, 1, 2, 3, 4, 5, 6, 7, 8, 9, 10, 11, 12, 13, 14, 15))
#define PG8_MMA(ai, bj, At, Bt) do { __builtin_amdgcn_s_setprio(1); \
        if constexpr (Epi::FP8) { _Pragma("unroll") for (int m = 0; m < 4; ++m) _Pragma("unroll") for (int n = 0; n < 2; ++n) \
            asm volatile("v_mfma_f32_16x16x128_f8f6f4 %0, %1, %2, %0" : "+v"(acc[ai][bj][m][n]) : "v"(PG8_CAT(Bt[n][0], Bt[n][1])), "v"(PG8_CAT(At[m][0], At[m][1]))); } \
          \
          \
        else { _Pragma("unroll") for (int m = 0; m < 4; ++m) _Pragma("unroll") for (int n = 0; n < 2; ++n) _Pragma("unroll") for (int k = 0; k < 2; ++k) \
            acc[ai][bj][m][n] = __builtin_amdgcn_mfma_f32_16x16x32_bf16(Bt[n][k], At[m][k], acc[ai][bj][m][n], 0, 0, 0); } \
        __builtin_amdgcn_s_setprio(0); } while (0)
#ifndef PG8_RELAX
#define PG8_RELAX 0
#endif
#ifndef PROBE_EPI_STORE
#define PROBE_EPI_STORE 1
#endif
#if defined(PROBE_EPI_REPS)
#define PG8_EPI_AGAIN do { if constexpr (Epi::IDEMP) { _Pragma("unroll 1") for (int r_ = 0; r_ < PROBE_EPI_REPS; ++r_) { asm volatile("" ::: "memory"); int l3 = lane_id(); asm volatile("" : "+v"(l3)); E.template body<(PROBE_EPI_STORE != 0)>(acc, cur, wr, wc, l3 & 15, l3 >> 4); } } } while (0)
#else
#define PG8_EPI_AGAIN do { } while (0)
#endif
#define PG8_WAIT_V(n) asm volatile("s_waitcnt vmcnt(" #n ")" ::: "memory")
#define PG8_WAIT_L(n) asm volatile("s_waitcnt lgkmcnt(" #n ")" ::: "memory")
#define PG8_BAR __builtin_amdgcn_s_barrier()
#define PG8_SCHED __builtin_amdgcn_sched_barrier(0)
    Unit cur, nxt; int ui = 0;
    if (!S.next(0, cur)) return;
    f32x4 acc[2][2][4][2];
#pragma unroll
    for (int a = 0; a < 2; ++a)
#pragma unroll
        for (int b = 0; b < 2; ++b)
#pragma unroll
            for (int m = 0; m < 4; ++m)
#pragma unroll
                for (int n = 0; n < 2; ++n) acc[a][b][m][n] = (f32x4){0.f, 0.f, 0.f, 0.f};
    bf16x8 At[4][2], B0[2][2], B1[2][2];
    const size_t tstepA = (g.K < 0) ? 0 : tstep, tstepB = tstepA;
    const char* cA = (const char*)g.A + (size_t)cur.pm * tstepA; const char* cB = (const char*)g.Bt + (size_t)cur.pn * tstepB;
    S.a_ready(cur);
    if constexpr (SP2) {
        PG8_STAGE(PG8_SB(0, 0), cB, voffB); PG8_STAGE(PG8_SB(0, 1), cB + hstep, voffB); PG8_STAGE(PG8_SA(0, 0), cA, voffA); PG8_STAGE(PG8_SA(0, 1), cA + hstep, voffA);
        if (wr == 1) PG8_BAR;
        PG8_WAIT_V(2); PG8_BAR;
        PG8_STAGE(PG8_SB(1, 0), cB + kstepB, voffB); PG8_STAGE(PG8_SA(1, 0), cA + kstepA, voffA); PG8_STAGE(PG8_SB(1, 1), cB + hstep + kstepB, voffB);
        PG8_WAIT_V(6); PG8_BAR;
    } else {
        PG8_STAGE(PG8_SB(0, 0), cB, voffB); PG8_STAGE(PG8_SA(0, 0), cA, voffA); PG8_STAGE(PG8_SB(0, 1), cB + hstep, voffB); PG8_STAGE(PG8_SA(0, 1), cA + hstep, voffA);
        if (wr == 1) PG8_BAR;
        PG8_WAIT_V(4); PG8_BAR;
        PG8_STAGE(PG8_SB(1, 0), cB + kstepB, voffB); PG8_STAGE(PG8_SA(1, 0), cA + kstepA, voffA); PG8_STAGE(PG8_SB(1, 1), cB + hstep + kstepB, voffB);
        PG8_WAIT_V(6); PG8_BAR;
    }
    for (;;) {
        const bool has_next = S.next(ui + 1, nxt);
        const char* nA = has_next ? (const char*)g.A + (size_t)nxt.pm * tstepA : cA; const char* nB = has_next ? (const char*)g.Bt + (size_t)nxt.pn * tstepB : cB;
#pragma unroll 1
        for (int t = 0; t < nt; t += 2) {
            const bool last = (t == nt - 2);
            const char* a1 = cA + (size_t)(t + 1) * kstepA;
            const char* a2 = last ? nA : cA + (size_t)(t + 2) * kstepA; const char* b2 = last ? nB : cB + (size_t)(t + 2) * kstepB;
            const char* a3 = a2 + kstepA; const char* b3 = b2 + kstepB;
            if (last && has_next) S.a_ready(nxt);
            if constexpr (SP2) {
            const bool relax = PG8_RELAX && t == 0 && ui > 0;
            PG8_LDB(B0, 0, 0); PG8_LDB(B1, 0, 1); PG8_SCHED; PG8_LDA(At, 0, 0); PG8_STAGE(PG8_SA(1, 1), a1 + hstep, voffA);
            if (relax) PG8_WAIT_V(24); else PG8_WAIT_V(8);
            PG8_WAIT_L(0); PG8_BAR; PG8_MMA(0, 0, At, B0); PG8_MMA(0, 1, At, B1); PG8_BAR; PG8_SCHED;
            PG8_LDA(At, 0, 1); PG8_STAGE(PG8_SB(0, 0), b2, voffB); PG8_STAGE(PG8_SB(0, 1), b2 + hstep, voffB); PG8_STAGE(PG8_SA(0, 0), a2, voffA);
            if (relax) PG8_WAIT_V(24); else PG8_WAIT_V(8);
            PG8_WAIT_L(0); PG8_BAR; PG8_MMA(1, 0, At, B0); PG8_MMA(1, 1, At, B1); PG8_BAR; PG8_SCHED;
            PG8_LDB(B0, 1, 0); PG8_LDB(B1, 1, 1); PG8_SCHED; PG8_LDA(At, 1, 0); PG8_STAGE(PG8_SA(0, 1), a2 + hstep, voffA);
            PG8_WAIT_V(8); PG8_WAIT_L(0); PG8_BAR; PG8_MMA(0, 0, At, B0); PG8_MMA(0, 1, At, B1); PG8_BAR; PG8_SCHED;
            PG8_LDA(At, 1, 1); PG8_STAGE(PG8_SB(1, 0), b3, voffB); PG8_STAGE(PG8_SB(1, 1), b3 + hstep, voffB); PG8_STAGE(PG8_SA(1, 0), a3, voffA);
            PG8_WAIT_V(8); PG8_WAIT_L(0); PG8_BAR; PG8_MMA(1, 0, At, B0); PG8_MMA(1, 1, At, B1); PG8_BAR; PG8_SCHED;
            } else {
            PG8_LDB(B0, 0, 0); PG8_SCHED; PG8_LDA(At, 0, 0); PG8_STAGE(PG8_SA(1, 1), a1 + hstep, voffA);
            PG8_WAIT_L(8); PG8_BAR; PG8_WAIT_L(0); PG8_MMA(0, 0, At, B0); PG8_BAR; PG8_SCHED;
            PG8_LDB(B1, 0, 1); PG8_STAGE(PG8_SB(0, 0), b2, voffB);
            PG8_BAR; PG8_WAIT_L(0); PG8_MMA(0, 1, At, B1); PG8_BAR;
            PG8_LDA(At, 0, 1); PG8_STAGE(PG8_SA(0, 0), a2, voffA);
            PG8_BAR; PG8_WAIT_L(0); PG8_MMA(1, 0, At, B0); PG8_BAR; PG8_SCHED;
            PG8_STAGE(PG8_SB(0, 1), b2 + hstep, voffB);
            PG8_WAIT_V(6); PG8_BAR; PG8_MMA(1, 1, At, B1); PG8_BAR;
            PG8_LDB(B0, 1, 0); PG8_SCHED; PG8_LDA(At, 1, 0); PG8_STAGE(PG8_SA(0, 1), a2 + hstep, voffA);
            PG8_WAIT_L(8); PG8_BAR; PG8_WAIT_L(0); PG8_MMA(0, 0, At, B0); PG8_BAR; PG8_SCHED;
            PG8_LDB(B1, 1, 1); PG8_STAGE(PG8_SB(1, 0), b3, voffB);
            PG8_BAR; PG8_WAIT_L(0); PG8_MMA(0, 1, At, B1); PG8_BAR;
            PG8_LDA(At, 1, 1); PG8_STAGE(PG8_SA(1, 0), a3, voffA);
            PG8_BAR; PG8_WAIT_L(0); PG8_MMA(1, 0, At, B0); PG8_BAR; PG8_SCHED;
            PG8_STAGE(PG8_SB(1, 1), b3 + hstep, voffB);
            PG8_WAIT_V(6); PG8_BAR; PG8_MMA(1, 1, At, B1); PG8_BAR;
            }
        }
        if constexpr (ALIGN_EPI) { if (wr == 0) PG8_BAR; }
        if constexpr (Epi::FP8) asm volatile("s_nop 15\n\ts_nop 15" ::: "memory");
        if constexpr (!Epi::AFTER_DRAIN) { int l2 = lane_id(); asm volatile("" : "+v"(l2)); E(acc, cur, wr, wc, l2 & 15, l2 >> 4); PG8_EPI_AGAIN; S.done(cur); }
        if (!has_next) break;
#pragma unroll
        for (int a = 0; a < 2; ++a)
#pragma unroll
            for (int b = 0; b < 2; ++b)
#pragma unroll
                for (int m = 0; m < 4; ++m)
#pragma unroll
                    for (int n = 0; n < 2; ++n) acc[a][b][m][n] = (f32x4){0.f, 0.f, 0.f, 0.f};
        cur = nxt; cA = nA; cB = nB; ++ui;
        if constexpr (ALIGN_EPI) { if (wr == 1) PG8_BAR; }
    }
    PG8_WAIT_V(0);
    if constexpr (!ALIGN_EPI) { if (wr == 0) PG8_BAR; }
    PG8_BAR;
    if constexpr (Epi::AFTER_DRAIN) { E.fused(acc, cur, wr, wc, fr, fq, lds, wid, lane); S.done(cur); }
#undef PG8_SA
#undef PG8_SB
#undef PG8_STAGE
#undef PG8_LDA
#undef PG8_LDB
#undef PG8_MMA
#undef PG8_CAT
#undef PG8_WAIT_V
#undef PG8_WAIT_L
#undef PG8_BAR
#undef PG8_SCHED
}
}
constexpr int NWAVES = 8;
constexpr int BATCH = 4, SEQ = 2048, DM = 4096, DEPTH = 2, AW = 2048, NH = 16, HD = 128, SW = 2048, NG = 128, NP = 64, NC = 16, DFF = 16384, PLE = 256, INW = 16384;
constexpr int M = BATCH * SEQ;
constexpr float RMS_EPS = 1e-6f;
#ifndef MK_N_LAUNCHES
#define MK_N_LAUNCHES 1
#endif
constexpr int PH_PER_LAYER = 8, N_PHASES = 2 + DEPTH * PH_PER_LAYER + 1;

constexpr size_t MiB = 1u << 20;
constexpr size_t WS_CTL = 0, CTL_ZERO_BYTES = 1 * MiB;
constexpr size_t WS_W = 1 * MiB, W_LAYER = 490 * MiB;
constexpr size_t WO_IN = 0, WO_BRA = 128 * MiB, WO_GLU = 144 * MiB, WO_BRS = 152 * MiB, WO_O = 168 * MiB, WO_FF1 = 200 * MiB, WO_FF2 = 328 * MiB, WO_PG = 456 * MiB, WO_PLE = 488 * MiB;
constexpr size_t WS_SSM = WS_W + 2 * W_LAYER, SSM_LAYER = 33 * MiB;
constexpr size_t SO_T = 0, SO_E = 16 * MiB, SO_F = 24 * MiB, SO_L16 = 32 * MiB;
constexpr size_t WS_H = WS_SSM + 2 * SSM_LAYER;
constexpr size_t WS_PB = WS_H + 128 * MiB;
constexpr size_t WS_PE = WS_PB + 8 * MiB;
constexpr size_t WS_ACT = WS_PE + 128 * MiB;
constexpr size_t AO_Q = 0, AO_K = 32 * MiB, AO_VP = 64 * MiB, AO_U = 96 * MiB, AO_ATT = 128 * MiB, AO_Y = 160 * MiB, AO_SSM = 192 * MiB, AO_SA = 224 * MiB, AO_SS = 288 * MiB, AO_TMP = 352 * MiB, AO_MRG = 416 * MiB;
static_assert(AO_Q == 0 && AO_K == 32 * MiB && AO_VP == 64 * MiB && AO_U == 96 * MiB && AO_SA == 224 * MiB && AO_SS == 288 * MiB, "EpiIn's pointer arithmetic");
constexpr size_t WS_MID = WS_ACT;
constexpr size_t WS_H8 = WS_ACT + 480 * MiB;
constexpr size_t WS_Y8 = WS_H8 + 64 * MiB;
constexpr size_t WS_END = WS_Y8 + 16 * MiB;
constexpr size_t CTL_SS = 256 * 1024;
constexpr int CW_BAR = 4096;

constexpr int LDS_BYTES = 155648;
constexpr int MISC_OFF = LDS_BYTES - 256;

#define GAS __attribute__((address_space(1)))
#define LAS __attribute__((address_space(3)))
typedef unsigned short bf16;
typedef unsigned v4u __attribute__((ext_vector_type(4)));
typedef unsigned v2u __attribute__((ext_vector_type(2)));
typedef float f32x4 __attribute__((ext_vector_type(4)));
typedef float f32x2 __attribute__((ext_vector_type(2)));
typedef float f32x16 __attribute__((ext_vector_type(16)));
typedef short bf16x8 __attribute__((ext_vector_type(8)));
typedef __bf16 bf16x2v __attribute__((ext_vector_type(2)));
typedef GAS unsigned gu32;
#define RLX_AGENT __ATOMIC_RELAXED, __HIP_MEMORY_SCOPE_AGENT
#define LDS_WAIT() asm volatile("s_waitcnt lgkmcnt(0)" ::: "memory")
#define VM_WAIT() asm volatile("s_waitcnt vmcnt(0)" ::: "memory")
#define MFMA32(a, b, c) __builtin_amdgcn_mfma_f32_32x32x16_bf16((a), (b), (c), 0, 0, 0)
__device__ __forceinline__ unsigned pk2(float lo, float hi) { const f32x2 v = {lo, hi}; return __builtin_bit_cast(unsigned, __builtin_convertvector(v, bf16x2v)); }
__device__ __forceinline__ float bflo(unsigned w) { return __uint_as_float(w << 16); }
__device__ __forceinline__ float bfhi(unsigned w) { return __uint_as_float(w & 0xffff0000u); }
__device__ __forceinline__ int crow(int i, int h) { return (i & 3) + 8 * (i >> 2) + 4 * h; }
#define XB_TMO      128
#define XB_XCNT(j)  (256  + 64 * (j))
#define XB_XSUB(j)  (1280 + 64 * (j))
#define XB_XGEN(j)  (2304 + 64 * (j))
#define XB_TOP      3328
#define XB_TOPGEN   3392
#define XCD_BAR_WORDS 3456
#define XB_SPIN_CAP (1u << 18)

__device__ __forceinline__ unsigned xb_ld(unsigned* p)              { return __hip_atomic_load(p, __ATOMIC_RELAXED, __HIP_MEMORY_SCOPE_AGENT); }
__device__ __forceinline__ unsigned xb_add(unsigned* p, unsigned v) { return __hip_atomic_fetch_add(p, v, __ATOMIC_RELAXED, __HIP_MEMORY_SCOPE_AGENT); }
__device__ __forceinline__ unsigned xb_xcc_id() { return (unsigned)__builtin_amdgcn_s_getreg((3 << 11) | 20) & 0xFu; }
#define XB_SPIN(cond, bar) do { unsigned _sp = 0; while (cond) { __builtin_amdgcn_s_sleep(1); \
    if ((++_sp & 255u) == 0u) { if (xb_ld(&(bar)[XB_TMO])) break; if (_sp > XB_SPIN_CAP) { atomicAdd(&(bar)[XB_TMO], 1u); break; } } } } while (0)

struct XcdBarrier {
    unsigned* bar; unsigned x; bool t0;
    volatile LAS unsigned* st;
};

__device__ __forceinline__ XcdBarrier xcd_barrier_post(unsigned* bar, volatile LAS unsigned* st) {
    XcdBarrier b; b.bar = bar; b.x = xb_xcc_id(); b.st = st; b.t0 = (threadIdx.x == 0);
    if (threadIdx.x == 0) (void)xb_add(&bar[XB_XCNT(b.x)], 1u);
    return b;
}
__device__ __forceinline__ void xcd_barrier_complete(unsigned* bar, unsigned x, unsigned& nloc, unsigned& nx) {
    const unsigned G = gridDim.x * gridDim.y * gridDim.z;
    unsigned sum, cnt, mine, sp = 0u;
    for (;;) {
        sum = 0u; cnt = 0u; mine = 0u;
#pragma unroll
        for (unsigned j = 0; j < 16; ++j) { const unsigned c = xb_ld(&bar[XB_XCNT(j)]); sum += c; cnt += (c > 0u) ? 1u : 0u; mine = (j == x) ? c : mine; }
        if (sum == G) break;
        __builtin_amdgcn_s_sleep(1);
        if ((++sp & 255u) == 0u) { if (xb_ld(&bar[XB_TMO])) break; if (sp > XB_SPIN_CAP) { atomicAdd(&bar[XB_TMO], 1u); break; } }
    }
    nloc = mine > 0u ? mine : 1u; nx = cnt > 0u ? cnt : 1u;
}

__device__ __forceinline__ void xcd_barrier(const XcdBarrier& b) {
    asm volatile("s_waitcnt vmcnt(0)" ::: "memory");
    __syncthreads();
    if (b.t0) {
        unsigned* bar = b.bar;
        __builtin_amdgcn_s_waitcnt(0);
        unsigned nloc = b.st[0], nx = b.st[1];
        if (nloc == 0u) { xcd_barrier_complete(bar, b.x, nloc, nx); b.st[0] = nloc; b.st[1] = nx; }
        const unsigned old = xb_add(&bar[XB_XSUB(b.x)], 1u);
        const unsigned gen = old / nloc;
        if (old + 1u == (gen + 1u) * nloc) {
            __builtin_amdgcn_fence(__ATOMIC_RELEASE, "agent");
            asm volatile("s_waitcnt vmcnt(0)" ::: "memory");
            const unsigned og = xb_add(&bar[XB_TOP], 1u);
            const unsigned tg = og / nx;
            if (og + 1u == (tg + 1u) * nx) xb_add(&bar[XB_TOPGEN], 1u);
            else XB_SPIN(xb_ld(&bar[XB_TOPGEN]) == tg, bar);
            __builtin_amdgcn_fence(__ATOMIC_ACQUIRE, "agent");
            xb_add(&bar[XB_XGEN(b.x)], 1u);
            asm volatile("s_waitcnt vmcnt(0)" ::: "memory");
        } else {
            XB_SPIN(xb_ld(&bar[XB_XGEN(b.x)]) == gen, bar);
            __builtin_amdgcn_fence(__ATOMIC_ACQUIRE, "agent");
            asm volatile("s_waitcnt vmcnt(0)" ::: "memory");
        }
    }
    __syncthreads();
}

struct Args { const float* in[23]; float* out; unsigned char* ws; int ph_lo, ph_hi, li, pad; };
typedef __attribute__((address_space(4))) const Args* KArgP0;
enum { I_X = 0, I_P, I_GMIX, I_WIN, I_WBRA, I_LRE, I_LIM, I_LOGDT, I_BRE, I_BIM, I_CRE, I_CIM, I_DSKIP, I_WGLU, I_WBRS, I_WO, I_GMLP, I_WFF1, I_WFF2, I_GPLE, I_WPG, I_WPLE, I_GFIN };

__device__ __forceinline__ float wave_sum(float v) {
#pragma unroll
    for (int o = 1; o < 64; o <<= 1) v += __shfl_xor(v, o);
    return v;
}
struct TrDesc { const float* src; bf16* dst; const float* gk; int K; size_t N; int f8; };
constexpr int TR_IN = 16384, TR_BRA = 2048, TR_GLU = 1024, TR_BRS = 2048, TR_O = 4096, TR_FF1 = 16384, TR_FF2 = 16384, TR_PG = 4096, TR_PLE = 256;
constexpr int TR_LAYER = TR_IN + TR_BRA + TR_GLU + TR_BRS + TR_O + TR_FF1 + TR_FF2 + TR_PG + TR_PLE;
__device__ __forceinline__ TrDesc tr_desc(KArgP0 a, int it, int lane) {
    const int L = it / TR_LAYER; int r = it - L * TR_LAYER;
    unsigned char* wl = a->ws + WS_W + (size_t)L * W_LAYER;
    const float* W; int K, N; size_t wo; const float* gv = nullptr; int f8 = 0;
    int win = 0;
    if (r < TR_IN) { W = a->in[I_WIN] + (size_t)L * DM * INW; K = DM; N = INW; wo = WO_IN; gv = a->in[I_GMIX] + L * DM; win = 1; }
    else if ((r -= TR_IN) < TR_BRA) { W = a->in[I_WBRA] + (size_t)L * AW * DM; K = AW; N = DM; wo = WO_BRA; }
    else if ((r -= TR_BRA) < TR_GLU) { W = a->in[I_WGLU] + (size_t)L * SW * SW; K = SW; N = SW; wo = WO_GLU; f8 = 1; }
    else if ((r -= TR_GLU) < TR_BRS) { W = a->in[I_WBRS] + (size_t)L * SW * DM; K = SW; N = DM; wo = WO_BRS; }
    else if ((r -= TR_BRS) < TR_O) { W = a->in[I_WO] + (size_t)L * DM * DM; K = DM; N = DM; wo = WO_O; }
    else if ((r -= TR_O) < TR_FF1) { W = a->in[I_WFF1] + (size_t)L * DM * DFF; K = DM; N = DFF; wo = WO_FF1; gv = a->in[I_GMLP] + L * DM; }
    else if ((r -= TR_FF1) < TR_FF2) { W = a->in[I_WFF2] + (size_t)L * DFF * DM; K = DFF; N = DM; wo = WO_FF2; }
    else if ((r -= TR_FF2) < TR_PG) { W = a->in[I_WPG] + (size_t)L * DM * DM; K = DM; N = DM; wo = WO_PG; gv = a->in[I_GPLE] + L * DM; f8 = 1; }
    else { r -= TR_PG; W = a->in[I_WPLE] + (size_t)L * PLE * DM; K = PLE; N = DM; wo = WO_PLE; }
    const int nblk = N >> 6, kb = r / nblk, nb = r - kb * nblk, k0 = kb * 64, n0 = nb * 64;
    TrDesc t; t.src = W + (size_t)(k0 + (lane >> 4)) * N + n0 + 4 * (lane & 15); t.dst = (bf16*)(wl + wo) + ((size_t)kb * N + n0 + (lane >> 3)) * 64 + 8 * (lane & 7); t.K = 64; t.N = (size_t)N; t.gk = gv ? gv + k0 + 8 * (lane & 7) : nullptr; t.f8 = f8;
    if (f8) t.dst = (bf16*)((unsigned char*)(wl + wo) + ((size_t)(k0 >> 7) * N + n0 + (lane >> 3)) * 128 + (k0 & 127) + 8 * (lane & 7));
    if (win) {
        if (n0 < 8192) t.dst = (bf16*)(wl + wo) + ((size_t)kb * 8192 + n0 + (lane >> 3)) * 64 + 8 * (lane & 7);
        else { t.f8 = 1; t.dst = (bf16*)((unsigned char*)(wl + wo) + (64u << 20) + ((size_t)(k0 >> 7) * 8192 + (n0 - 8192) + (lane >> 3)) * 128 + (k0 & 127) + 8 * (lane & 7)); } }
    return t;
}
__device__ __forceinline__ void tr_load(f32x4 (&v)[16], const TrDesc& t) {
#pragma unroll
    for (int i = 0; i < 16; ++i) v[i] = __builtin_nontemporal_load((const f32x4*)(t.src + (size_t)(4 * i) * t.N));
}
__device__ __forceinline__ void tr_store(const f32x4 (&v)[16], const TrDesc& t, LAS float* scr, int lane) {
    LAS float* d = scr + (lane >> 4) * 65 + 4 * (lane & 15);
#pragma unroll
    for (int i = 0; i < 16; ++i) { LAS float* dd = d + (4 * i) * 65; dd[0] = v[i].x; dd[1] = v[i].y; dd[2] = v[i].z; dd[3] = v[i].w; }
    LDS_WAIT(); asm volatile("" ::: "memory");
    const LAS float* s0 = scr + (8 * (lane & 7)) * 65 + (lane >> 3);
    f32x4 g0 = {1.f, 1.f, 1.f, 1.f}, g1 = g0; if (t.gk) { g0 = *(const f32x4*)t.gk; g1 = *(const f32x4*)(t.gk + 4); }
    if (t.f8) { g0 = g0 * pg8::F8_WSCALE; g1 = g1 * pg8::F8_WSCALE; }
#pragma unroll
    for (int jj = 0; jj < 8; ++jj) { const LAS float* s = s0 + 8 * jj;
        if (t.f8) { v2u q; q.x = pg8::pk4_fp8(s[0] * g0.x, s[65] * g0.y, s[2 * 65] * g0.z, s[3 * 65] * g0.w); q.y = pg8::pk4_fp8(s[4 * 65] * g1.x, s[5 * 65] * g1.y, s[6 * 65] * g1.z, s[7 * 65] * g1.w);
            __builtin_nontemporal_store(q, (v2u*)(t.dst + (size_t)(8 * jj) * t.K)); continue; }
        v4u o; o.x = pk2(s[0] * g0.x, s[65] * g0.y); o.y = pk2(s[2 * 65] * g0.z, s[3 * 65] * g0.w); o.z = pk2(s[4 * 65] * g1.x, s[5 * 65] * g1.y); o.w = pk2(s[6 * 65] * g1.z, s[7 * 65] * g1.w);
        __builtin_nontemporal_store(o, (v4u*)(t.dst + (size_t)(8 * jj) * t.K)); }
    LDS_WAIT(); asm volatile("" ::: "memory");
}
__device__ __forceinline__ void tr_all(KArgP0 a, int gw, int NGW, LAS float* scr, int lane) {
    constexpr int NIT = DEPTH * TR_LAYER;
    int it = gw; if (it >= NIT) return;
    f32x4 va[16], vb[16];
    TrDesc ta = tr_desc(a, it, lane), tb = ta; tr_load(va, ta);
    for (;;) {
        const bool hb = (it + NGW < NIT); if (hb) { tb = tr_desc(a, it + NGW, lane); tr_load(vb, tb); }
        tr_store(va, ta, scr, lane); if (!hb) break; it += NGW;
        const bool ha = (it + NGW < NIT); if (ha) { ta = tr_desc(a, it + NGW, lane); tr_load(va, ta); }
        tr_store(vb, tb, scr, lane); if (!ha) break; it += NGW;
    }
}
__device__ __forceinline__ void tr_all_dyn(KArgP0 a, unsigned* ctr, volatile LAS unsigned* slot, int wave, LAS float* scr, int lane) {
    constexpr unsigned NIT = DEPTH * TR_LAYER;
    const bool lead = (wave == 0) && (lane == 0);
    if (lead) { slot[2] = atomicAdd(ctr, 16u); slot[1] = atomicAdd(ctr, 16u); }
    __syncthreads();
    unsigned base = slot[2];
    if (base >= NIT) return;
    f32x4 va[16], vb[16];
    TrDesc ta = tr_desc(a, (int)base + wave, lane), tb = ta; tr_load(va, ta);
    for (unsigned r = 0;; ++r) {
        unsigned nb2 = 0u; if (lead) nb2 = atomicAdd(ctr, 16u);
        tb = tr_desc(a, (int)base + 8 + wave, lane); tr_load(vb, tb);
        tr_store(va, ta, scr, lane);
        const unsigned nbase = slot[(r + 1) & 1]; const bool more = nbase < NIT;
        if (more) { ta = tr_desc(a, (int)nbase + wave, lane); tr_load(va, ta); }
        tr_store(vb, tb, scr, lane);
        if (lead) slot[r & 1] = nb2;
        __syncthreads();
        if (!more) break;
        base = nbase;
    }
}
#ifndef ROT_FF1
#define ROT_FF1 1
#endif
#ifndef ROT_IN
#define ROT_IN 0
#endif
struct RotOrder : pg8::StaticOrder {
    __device__ __forceinline__ bool next(int i, pg8::Unit& u) const {
        if (!pg8::StaticOrder::next(i, u)) return false;
        if (nM == 32 && nN == 16 && G == 256 && (i & 1)) { u.pm ^= 16; u.pn ^= 8; }
        if (ROT_FF1 && nM == 32 && nN == 64 && G == 256) { if (i & 1) u.pn ^= 32; if (i & 2) u.pm ^= 16; if (i & 4) u.pm ^= 8; }
        if (ROT_IN && nM == 32 && nN == 32 && G == 256) { if (i & 1) u.pn ^= 16; if (i & 2) u.pm ^= 16; }
        return true;
    }
};
struct HalfMOrder : pg8::StaticOrder {
    __device__ __forceinline__ bool next(int i, pg8::Unit& u) const {
        if (!(G == 256 && nM == 32 && nN == 16)) return pg8::StaticOrder::next(i, u);
        i += ibeg; if (i >= iend || i >= 2) return false;
        const int x = c & 7, loc = c >> 3;
        u.pm = i * 16 + (x & 1) * 8 + (loc & 7); u.pn = (x >> 1) * 4 + (loc >> 3); return true;
    }
};
struct QkvuOrder : pg8::StaticOrder {
    __device__ __forceinline__ bool next(int i, pg8::Unit& u) const {
        if (!pg8::StaticOrder::next(i, u)) return false;
        if (G == 256 && nN == 32 && (i & 1)) u.pn ^= 16;
        if (ROT_IN && G == 256 && nN == 32 && nM == 32 && (i & 2)) u.pm ^= 16;
        return true;
    }
};
__device__ __forceinline__ void ssm_prep(KArgP0 a, int L, int g, LAS unsigned char* lds, int tid) {
    LAS float* lamp = (LAS float*)lds;
    LAS float* bbar = lamp + 64 * 17 * 2;
    LAS float* ccv = bbar + 64 * 16 * 2;
    LAS float* Kd = ccv + 16 * 64 * 2;
    const int lg = L * NG + g;
    const float* lre = a->in[I_LRE] + lg * NP; const float* lim = a->in[I_LIM] + lg * NP;
    const float* bre = a->in[I_BRE] + (size_t)lg * NP * NC; const float* bim = a->in[I_BIM] + (size_t)lg * NP * NC;
    const float* cre = a->in[I_CRE] + (size_t)lg * NC * NP; const float* cim = a->in[I_CIM] + (size_t)lg * NC * NP;
    const float dt = expf(a->in[I_LOGDT][lg]);
    for (int t = tid; t < 64 * 17; t += 512) { const int p = t / 17, d = t - 17 * p; const float ar = lre[p] * dt * (float)d, th = lim[p] * dt * (float)d, e = expf(ar);
        lamp[2 * t] = e * cosf(th); lamp[2 * t + 1] = e * sinf(th); }
    for (int t = tid; t < 64 * 16; t += 512) { const int p = t >> 4; const float lr = lre[p], li = lim[p], ar = lr * dt, th = li * dt;
        const float ea = expf(ar), em1 = expm1f(ar), sn = sinf(th), cs = cosf(th), sh = sinf(0.5f * th);
        const float nr = em1 * cs - 2.f * sh * sh, ni = ea * sn, den = lr * lr + li * li;
        const float cr = (nr * lr + ni * li) / den, ci = (ni * lr - nr * li) / den;
        const float br = bre[t], bi = bim[t];
        bbar[2 * t] = cr * br - ci * bi; bbar[2 * t + 1] = cr * bi + ci * br;
        ccv[2 * t] = cre[t]; ccv[2 * t + 1] = cim[t]; }
    __syncthreads();
    for (int t = tid; t < 4096; t += 512) { const int d = t >> 8, c = (t >> 4) & 15, c2 = t & 15; float acc = 0.f;
        for (int p = 0; p < 64; ++p) { const float cr = ccv[2 * (c * 64 + p)], ci = ccv[2 * (c * 64 + p) + 1], lr = lamp[2 * (p * 17 + d)], li = lamp[2 * (p * 17 + d) + 1];
            const float br = bbar[2 * (p * 16 + c2)], bi = bbar[2 * (p * 16 + c2) + 1], xr = cr * lr - ci * li, xi = cr * li + ci * lr; acc += xr * br - xi * bi; }
        Kd[t] = acc; }
    __syncthreads();
    unsigned char* sl = a->ws + WS_SSM + (size_t)L * SSM_LAYER;
    bf16* Tg = (bf16*)(sl + SO_T) + (size_t)g * 256 * 256; bf16* Eg = (bf16*)(sl + SO_E) + (size_t)g * 128 * 256; bf16* Fg = (bf16*)(sl + SO_F) + (size_t)g * 256 * 128;
    for (int ch = tid; ch < 8192; ch += 512) { const int n = ch >> 5, kc = ch & 31, i = n >> 4, c = n & 15, j = kc >> 1, c20 = (kc & 1) * 8; float v[8];
#pragma unroll
        for (int e = 0; e < 8; ++e) v[e] = (j <= i) ? Kd[((i - j) * 16 + c) * 16 + c20 + e] : 0.f;
        v4u o; o.x = pk2(v[0], v[1]); o.y = pk2(v[2], v[3]); o.z = pk2(v[4], v[5]); o.w = pk2(v[6], v[7]); *(v4u*)(Tg + ((size_t)(((n >> 5) * 16 + (kc >> 1)) * 64) + (kc & 1) * 32 + (n & 31)) * 8) = o; }
    for (int ch = tid; ch < 4096; ch += 512) { const int n = ch >> 5, kc = ch & 31, p = n >> 1, ri = n & 1, j = kc >> 1, c20 = (kc & 1) * 8; float v[8];
        const float lr = lamp[2 * (p * 17 + 15 - j)], li = lamp[2 * (p * 17 + 15 - j) + 1];
#pragma unroll
        for (int e = 0; e < 8; ++e) { const float br = bbar[2 * (p * 16 + c20 + e)], bi = bbar[2 * (p * 16 + c20 + e) + 1]; v[e] = ri ? (lr * bi + li * br) : (lr * br - li * bi); }
        v4u o; o.x = pk2(v[0], v[1]); o.y = pk2(v[2], v[3]); o.z = pk2(v[4], v[5]); o.w = pk2(v[6], v[7]); *(v4u*)(Eg + ((size_t)(((n >> 5) * 16 + (kc >> 1)) * 64) + (kc & 1) * 32 + (n & 31)) * 8) = o; }
    for (int ch = tid; ch < 4096; ch += 512) { const int n = ch >> 4, kc = ch & 15, i = n >> 4, c = n & 15; float v[8];
#pragma unroll
        for (int e = 0; e < 8; ++e) { const int kk = 8 * kc + e, p = kk >> 1; const float cr = ccv[2 * (c * 64 + p)], ci = ccv[2 * (c * 64 + p) + 1], lr = lamp[2 * (p * 17 + i + 1)], li = lamp[2 * (p * 17 + i + 1) + 1];
            v[e] = (kk & 1) ? -(cr * li + ci * lr) : (cr * lr - ci * li); }
        v4u o; o.x = pk2(v[0], v[1]); o.y = pk2(v[2], v[3]); o.z = pk2(v[4], v[5]); o.w = pk2(v[6], v[7]); *(v4u*)(Fg + ((size_t)(((n >> 5) * 8 + (kc >> 1)) * 64) + (kc & 1) * 32 + (n & 31)) * 8) = o; }
    if (tid < 64) { float* l16 = (float*)(sl + SO_L16) + (size_t)(g * 64 + tid) * 2; l16[0] = lamp[2 * (tid * 17 + 16)]; l16[1] = lamp[2 * (tid * 17 + 16) + 1]; }
    __syncthreads();
}
__device__ __forceinline__ void rms_row_f32(const bf16* H, int m, const float* g, float* orow, int lane) {
    f32x4 v[16]; float s = 0.f;
#pragma unroll
    for (int j = 0; j < 16; ++j) { const v2u w = *(const v2u*)(H + ((size_t)(4 * j + (lane >> 4)) * M + m) * 64 + 4 * (lane & 15)); v[j] = (f32x4){bflo(w.x), bfhi(w.x), bflo(w.y), bfhi(w.y)}; s += (v[j].x * v[j].x + v[j].y * v[j].y) + (v[j].z * v[j].z + v[j].w * v[j].w); }
    const float rs = 1.0f / sqrtf(wave_sum(s) * (1.0f / DM) + RMS_EPS);
    const f32x4* gr = (const f32x4*)g + lane;
#pragma unroll
    for (int j = 0; j < 16; ++j) { const f32x4 gg = gr[64 * j]; ((f32x4*)orow + lane)[64 * j] = v[j] * rs * gg; }
}
__device__ __forceinline__ void prenorm_row(const float* xrow, bf16* H, unsigned char* H8, int m, pg8::ssq_t* ss, int lane) {
    const f32x4* xr = (const f32x4*)xrow + lane; float s = 0.f;
#pragma unroll
    for (int j = 0; j < 16; ++j) { const f32x4 v = xr[64 * j]; s += (v.x * v.x + v.y * v.y) + (v.z * v.z + v.w * v.w);
        v2u hw; hw.x = pk2(v.x, v.y); hw.y = pk2(v.z, v.w); *(v2u*)(H + ((size_t)(4 * j + (lane >> 4)) * M + m) * 64 + 4 * (lane & 15)) = hw;
        *(unsigned*)(H8 + pg8::tix8(m, 4 * lane + 256 * j)) = pg8::pk4_fp8(v.x * pg8::F8_ASCALE, v.y * pg8::F8_ASCALE, v.z * pg8::F8_ASCALE, v.w * pg8::F8_ASCALE); }
    s = wave_sum(s); if (lane == 0) *ss = pg8::ss_enc(s);
}
__device__ __forceinline__ void stagger(int bid, unsigned window_ns) {
    if (window_ns == 0u) return;
    const unsigned ticks = (((unsigned)bid * 89u) & 255u) * window_ns / 2560u;
    const unsigned long long t0 = __builtin_amdgcn_s_memrealtime();
    while ((unsigned)(__builtin_amdgcn_s_memrealtime() - t0) < ticks) __builtin_amdgcn_s_sleep(2);
}
__device__ __forceinline__ void swap_halves(unsigned& a, unsigned& b) { const auto r = __builtin_amdgcn_permlane32_swap(a, b, false, false); a = r[0]; b = r[1]; }
__device__ __forceinline__ float gelu_tanh(float x) { const float u = 0.7978845608028654f * (x + 0.044715f * x * x * x); const float t = 1.0f - 2.0f / (__expf(2.0f * u) + 1.0f); return 0.5f * x * (1.0f + t); }
__device__ __forceinline__ void attn_wave(const bf16* Q, const bf16* Kb, const bf16* VP, bf16* O, int b, int h, int q0, int lane) {
    const int r = lane & 31, hh = lane >> 5;
    const float scale = 0.08838834764831845f;
    const size_t bh = (size_t)(b * NH + h);
    const bf16* qfp = Q + ((bh * 64 + (q0 >> 5)) * 8 * 64 + lane) * 8;
    bf16x8 qf[8];
#pragma unroll
    for (int ks = 0; ks < 8; ++ks) qf[ks] = *(const bf16x8*)(qfp + ks * 512);
    f32x16 o[4];
#pragma unroll
    for (int d = 0; d < 4; ++d)
#pragma unroll
        for (int i = 0; i < 16; ++i) o[d][i] = 0.f;
    float R = 1.f;
    const bf16* kbase = Kb + (bh * 64 * 8 * 64 + lane) * 8;
    const bf16* vbase = VP + (bh * 64 * 8 * 64 + lane) * 8;
    const int ktd = q0 >> 5;
    bf16x8 kf[8];
    { const bf16* kp = kbase + (size_t)ktd * 4096;
#pragma unroll
      for (int ks = 0; ks < 8; ++ks) kf[ks] = *(const bf16x8*)(kp + ks * 512); }
#pragma unroll 1
    for (int kt = ktd; kt >= 0; --kt) {
        bf16x8 vf[2][4];
#pragma unroll
        for (int sx = 0; sx < 2; ++sx)
#pragma unroll
            for (int db = 0; db < 4; ++db) vf[sx][db] = *(const bf16x8*)(vbase + (size_t)((kt * 4 + db) * 2 + sx) * 512);
        f32x16 s;
#pragma unroll
        for (int i = 0; i < 16; ++i) s[i] = 0.f;
#pragma unroll
        for (int ks = 0; ks < 8; ++ks) s = MFMA32(kf[ks], qf[ks], s);
        { const bf16* kp = kbase + (size_t)(kt > 0 ? kt - 1 : 0) * 4096;
#pragma unroll
          for (int ks = 0; ks < 8; ++ks) kf[ks] = *(const bf16x8*)(kp + ks * 512); }
        const bool diag = (kt == ktd);
        float be[16], om[16];
#pragma unroll
        for (int i = 0; i < 16; ++i) { const float z = s[i], a = __builtin_amdgcn_exp2f(-fabsf(z) * (scale * 1.4426950408889634f)), t = __builtin_amdgcn_rcpf(1.0f + a), u = a * t;
            const bool valid = !diag || (crow(i, hh) < r); const bool pos = z >= 0.f;
            be[i] = valid ? (pos ? t : u) : 0.f; om[i] = valid ? (pos ? u : t) : 1.f; }
        float gp[4], pg[4], tot[4];
#pragma unroll
        for (int g = 0; g < 4; ++g) { gp[g] = (om[4 * g] * om[4 * g + 1]) * (om[4 * g + 2] * om[4 * g + 3]); pg[g] = __shfl_xor(gp[g], 32); tot[g] = gp[g] * pg[g]; }
        float T[4]; T[3] = 1.f; T[2] = tot[3]; T[1] = tot[3] * tot[2]; T[0] = T[1] * tot[1];
        float w[16];
#pragma unroll
        for (int g = 0; g < 4; ++g) { float run = R * T[g] * (hh == 0 ? pg[g] : 1.f);
#pragma unroll
            for (int i = 4 * g + 3; i >= 4 * g; --i) { w[i] = be[i] * run; run *= om[i]; } }
        R *= T[0] * tot[0];
#pragma unroll
        for (int sx = 0; sx < 2; ++sx) {
            v4u pw; pw.x = pk2(w[8 * sx], w[8 * sx + 1]); pw.y = pk2(w[8 * sx + 2], w[8 * sx + 3]); pw.z = pk2(w[8 * sx + 4], w[8 * sx + 5]); pw.w = pk2(w[8 * sx + 6], w[8 * sx + 7]);
            const bf16x8 wf = __builtin_bit_cast(bf16x8, pw);
#pragma unroll
            for (int db = 0; db < 4; ++db) o[db] = MFMA32(vf[sx][db], wf, o[db]);
        }
        if (__all(R < 1e-37f)) break;
    }
    const int orow_ = b * SEQ + q0 + r, ocol_ = h * HD + 4 * hh;
#pragma unroll
    for (int db = 0; db < 4; ++db)
#pragma unroll
        for (int q = 0; q < 4; q += 2) { v2u a, c; a.x = pk2(o[db][4 * q], o[db][4 * q + 1]); a.y = pk2(o[db][4 * q + 2], o[db][4 * q + 3]); c.x = pk2(o[db][4 * q + 4], o[db][4 * q + 5]); c.y = pk2(o[db][4 * q + 6], o[db][4 * q + 7]);
            unsigned ax = a.x, ay = a.y, cx = c.x, cy = c.y; swap_halves(ax, cx); swap_halves(ay, cy);
            v4u ov; ov.x = ax; ov.y = ay; ov.z = cx; ov.w = cy; *(v4u*)(O + pg8::tix(orow_, h * HD + 32 * db + 8 * (q + hh))) = ov; }
}
__device__ __forceinline__ void ssm_unit(int b, int g, const bf16* U, const bf16* Tg, const bf16* Eg, const bf16* Fg, const float* l16, const float* dsk, bf16* Y, unsigned char* Y8, LAS unsigned char* lds, int wave, int lane, int mode = 0  ) {
    LAS unsigned char* UL = lds;
    LAS unsigned char* LE16 = lds + 65536;
    LAS unsigned char* SP = lds + 98304;
    const int r = lane & 31, hh = lane >> 5, tid = wave * 64 + lane;
    const int nt3 = wave; const bf16* tb = Tg + ((size_t)(nt3 * 16) * 64 + lane) * 8; const bf16* fb = Fg + ((size_t)(nt3 * 8) * 64 + lane) * 8;
    bf16x8 tf[16], ff[8];
#pragma unroll
    for (int s = 0; s < 16; ++s) tf[s] = *(const bf16x8*)(tb + s * 512);
#pragma unroll
    for (int s2 = 0; s2 < 8; ++s2) ff[s2] = *(const bf16x8*)(fb + s2 * 512);
    { const v4u* ug = (const v4u*)(U + (size_t)(b * NG + g) * 4 * 16 * 64 * 8) + tid; v4u t[8];
#pragma unroll
      for (int i = 0; i < 8; ++i) t[i] = ug[512 * i];
#pragma unroll
      for (int i = 0; i < 8; ++i) *(LAS v4u*)(UL + (size_t)(tid + 512 * i) * 16) = t[i]; }
    __syncthreads();
    { const int mt = wave >> 1, nt0 = 2 * (wave & 1);
      f32x16 a0, a1;
#pragma unroll
      for (int i = 0; i < 16; ++i) { a0[i] = 0.f; a1[i] = 0.f; }
      const bf16* e0 = Eg + ((size_t)(nt0 * 16) * 64 + lane) * 8; const bf16* e1 = e0 + 16 * 512;
      const LAS unsigned char* ul = UL + ((size_t)(mt * 16) * 64 + lane) * 16;
#pragma unroll 8
      for (int s = 0; s < 16; ++s) { const bf16x8 uf = *(const LAS bf16x8*)(ul + s * 1024); const bf16x8 b0 = *(const bf16x8*)(e0 + s * 512), b1 = *(const bf16x8*)(e1 + s * 512);
          a0 = MFMA32(uf, b0, a0); a1 = MFMA32(uf, b1, a1); }
#pragma unroll
      for (int i = 0; i < 16; ++i) { LAS unsigned char* row = LE16 + (32 * mt + crow(i, hh)) * 256;
          *(LAS unsigned short*)(row + (32 * nt0 + r) * 2) = (unsigned short)(pk2(a0[i], 0.f) & 0xffffu); *(LAS unsigned short*)(row + (32 * nt0 + 32 + r) * 2) = (unsigned short)(pk2(a1[i], 0.f) & 0xffffu); } }
    __syncthreads();
    if (wave == 0 && mode < 2) { const int p = lane; const float lr = l16[2 * p], li = l16[2 * p + 1]; float sr = 0.f, si = 0.f;
#pragma unroll 1
        for (int k0 = 0; k0 < 128; k0 += 8) { unsigned le[8];
#pragma unroll
            for (int j = 0; j < 8; ++j) le[j] = *(const LAS unsigned*)(LE16 + (k0 + j) * 256 + 4 * p);
#pragma unroll
            for (int j = 0; j < 8; ++j) { *(LAS unsigned*)(SP + (k0 + j) * 272 + 4 * p) = pk2(sr, si);
                const float nr = lr * sr - li * si + bflo(le[j]), ni = lr * si + li * sr + bfhi(le[j]); sr = nr; si = ni; } } }
    __syncthreads();
    { const int nt = nt3;
      f32x4 dk[4];
#pragma unroll
      for (int q = 0; q < 4; ++q) dk[q] = *(const f32x4*)(dsk + 16 * g + 8 * (q & 1) + 4 * hh);
#pragma unroll 1
        for (int mt = 0; mt < 4; ++mt) { const int chunk = 32 * mt + r; const LAS unsigned char* ul = UL + ((size_t)(mt * 16) * 64 + lane) * 16;
            f32x16 acc;
#pragma unroll
            for (int i = 0; i < 16; ++i) acc[i] = 0.f;
#pragma unroll
            for (int s = 0; s < 16; ++s) { const bf16x8 bfr = *(const LAS bf16x8*)(ul + s * 1024); acc = MFMA32(tf[s], bfr, acc); }
#pragma unroll
            for (int s2 = 0; s2 < 8; ++s2) { const bf16x8 bfr = *(const LAS bf16x8*)(SP + chunk * 272 + 32 * s2 + 16 * hh); acc = MFMA32(ff[s2], bfr, acc); }
#pragma unroll
            for (int tq = 0; tq < 2; ++tq) { const int itok = 2 * nt + tq; unsigned ovx[2], ovy[2], o8[2];
#pragma unroll
                for (int e = 0; e < 2; ++e) { const int q = 2 * tq + e;
                    const v2u uw = *(const LAS v2u*)(UL + ((size_t)((mt * 16 + itok) * 64 + e * 32 + r)) * 16 + 8 * hh);
                    const float y0 = gelu_tanh(acc[4 * q] + dk[q].x * bflo(uw.x)), y1 = gelu_tanh(acc[4 * q + 1] + dk[q].y * bfhi(uw.x)), y2 = gelu_tanh(acc[4 * q + 2] + dk[q].z * bflo(uw.y)), y3 = gelu_tanh(acc[4 * q + 3] + dk[q].w * bfhi(uw.y));
                    ovx[e] = pk2(y0, y1); ovy[e] = pk2(y2, y3); o8[e] = pg8::pk4_fp8(y0 * pg8::F8_ASCALE, y1 * pg8::F8_ASCALE, y2 * pg8::F8_ASCALE, y3 * pg8::F8_ASCALE); }
                swap_halves(ovx[0], ovx[1]); swap_halves(ovy[0], ovy[1]); swap_halves(o8[0], o8[1]);
                v4u yo; yo.x = ovx[0]; yo.y = ovy[0]; yo.z = ovx[1]; yo.w = ovy[1]; v2u y8; y8.x = o8[0]; y8.y = o8[1];
                if (mode == 0) { *(v4u*)(Y + pg8::tix(b * SEQ + 16 * chunk + itok, 16 * g + 8 * hh)) = yo; *(v2u*)(Y8 + pg8::tix8(b * SEQ + 16 * chunk + itok, 16 * g + 8 * hh)) = y8; }
                else asm volatile("" :: "v"(yo.x), "v"(yo.y), "v"(yo.z), "v"(yo.w), "v"(y8.x), "v"(y8.y)); } } }
    __syncthreads();
}
#ifndef GEMM_ALIGN
#define GEMM_ALIGN true
#endif
#ifndef GEMM_SP2
#define GEMM_SP2 true
#endif
typedef __attribute__((address_space(4))) const Args* KArgP;
__device__ __forceinline__ KArgP kargs() { unsigned long long p = (unsigned long long)__builtin_amdgcn_kernarg_segment_ptr(); asm volatile("" : "+s"(p)); return (KArgP)p; }
#ifndef PH_MASK
#if defined(PROBE_NOMIX)
#define PH_MASK (0xFFFF & ~0x78)
#else
#define PH_MASK 0xFFFF
#endif
#endif
#define ON(i) (((PH_MASK) >> (i)) & 1)
#ifndef REP_P0
#define REP_P0 1
#endif
#ifndef REP_NORM
#define REP_NORM 1
#endif
#ifndef REP_IN
#define REP_IN 1
#endif
#ifndef REP_ATT
#define REP_ATT 1
#endif
#ifndef REP_SSM
#define REP_SSM 1
#endif
#ifndef SSM_PROBE_MODE
#define SSM_PROBE_MODE 0
#endif
#ifndef REP_FF1
#define REP_FF1 1
#endif
#ifndef REP_GB
#define REP_GB 1
#endif
#ifndef STAGGER_IN_NS
#define STAGGER_IN_NS 0u
#endif
#ifndef STAGGER_FF1_NS
#define STAGGER_FF1_NS 0u
#endif
#ifndef PROBE_SKEW_XCD
#define PROBE_SKEW_XCD -1
#endif
#ifndef PROBE_SKEW_LASTX
#define PROBE_SKEW_LASTX -1
#endif
#ifndef PROBE_SKEW_MASK
#define PROBE_SKEW_MASK 0xffffffffu
#endif
#if defined(PROBE_SKEW)
#define PROBE_SKEW_STAMP(k) do { if (b_.t0 && (PROBE_SKEW_XCD < 0 || (int)b_.x == PROBE_SKEW_XCD)) { const unsigned long long t_ = __builtin_amdgcn_s_memrealtime(); unsigned long long* pk_ = (unsigned long long*)(A_->ws + WS_CTL + 131072); atomicMax(pk_ + 2 * (k), ~t_); if (PROBE_SKEW_LASTX < 0 || (int)b_.x == PROBE_SKEW_LASTX) atomicMax(pk_ + 2 * (k) + 1, t_); } } while (0)
#else
#define PROBE_SKEW_STAMP(k) do { } while (0)
#endif
#ifndef FF2_ORDER
#define FF2_ORDER HalfMOrder
#endif
#ifndef PROBE_SEAMX
#define PROBE_SEAMX 1
#endif
#ifndef REP_P1
#define REP_P1 1
#endif
#ifndef REP_PE
#define REP_PE 1
#endif
#ifndef REP_BRS
#define REP_BRS 1
#endif
__global__ void __launch_bounds__(NWAVES * 64, 2) fwd(Args args_unused) {
    extern __shared__ __attribute__((aligned(16))) unsigned char lds_raw[];
    LAS unsigned char* lds = (LAS unsigned char*)lds_raw;
    volatile LAS unsigned* MISC = (volatile LAS unsigned*)(lds + MISC_OFF);
    const int wave_s = __builtin_amdgcn_readfirstlane(threadIdx.x >> 6);
    if (threadIdx.x < 64) MISC[threadIdx.x] = 0u;
    __syncthreads();
    int lo, hi;
    { KArgP A = kargs(); lo = A->ph_lo; hi = A->ph_hi;
      if (hi - lo > 1) (void)xcd_barrier_post((unsigned*)(A->ws + WS_CTL) + CW_BAR, MISC + 8); }
#define IN(k) (lo <= (k) && (k) < hi)
#define SEAM(k) do { if (IN(k) && IN((k) + 1)) { KArgP A_ = kargs(); XcdBarrier b_; b_.bar = (unsigned*)(A_->ws + WS_CTL) + CW_BAR; b_.x = xb_xcc_id(); b_.st = MISC + 8; b_.t0 = (wave_s == 0) && (pg8::lane_id() == 0); PROBE_SKEW_STAMP(k); for (int sx_ = 0; sx_ < PROBE_SEAMX; ++sx_) xcd_barrier(b_); } } while (0)
#define GWS int lane = pg8::lane_id(); asm volatile("" : "+v"(lane)); const int wave = wave_s, tid = wave * 64 + lane; (void)tid; \
    const int G = gridDim.x, bid = blockIdx.x, gw = bid * NWAVES + wave, NGW = G * NWAVES; (void)gw; (void)NGW; (void)bid; (void)G

    for (int rep_ = 0; rep_ < REP_P0; ++rep_) if (ON(0) && IN(0)) { KArgP A = kargs(); unsigned char* ws = A->ws; GWS; __syncthreads();
        LAS float* scr = (LAS float*)(lds + wave * 16640);
        tr_all_dyn(A, (unsigned*)(ws + WS_CTL + 196608), MISC + 16, wave, scr, lane);
        { const float* P = A->in[I_P]; bf16* PB = (bf16*)(ws + WS_PB);
          for (int c = gw * 64 + lane; c < DEPTH * M * PLE / 8; c += NGW * 64) { const f32x4 a = *(const f32x4*)(P + (size_t)c * 8), b2 = *(const f32x4*)(P + (size_t)c * 8 + 4);
              v4u o; o.x = pk2(a.x, a.y); o.y = pk2(a.z, a.w); o.z = pk2(b2.x, b2.y); o.w = pk2(b2.z, b2.w);
              const int e_ = c * 8, L_ = e_ / (M * PLE), m_ = (e_ / PLE) % M, col_ = e_ % PLE; *(v4u*)(PB + (size_t)L_ * M * PLE + ((size_t)(col_ >> 6) * M + m_) * 64 + (col_ & 63)) = o; } }
#if defined(PROBE_STREAMCAST)
        {
            const int idx[9] = {I_WIN, I_WBRA, I_WGLU, I_WBRS, I_WO, I_WFF1, I_WFF2, I_WPG, I_WPLE};
            const size_t cnt[9] = {(size_t)DEPTH * DM * INW, (size_t)DEPTH * AW * DM, (size_t)DEPTH * SW * SW, (size_t)DEPTH * SW * DM, (size_t)DEPTH * DM * DM, (size_t)DEPTH * DM * DFF, (size_t)DEPTH * DFF * DM, (size_t)DEPTH * DM * DM, (size_t)DEPTH * PLE * DM};
            bf16* dead = (bf16*)(ws + WS_ACT); size_t wpos = 0;
#pragma unroll
            for (int q = 0; q < 9; ++q) { const float* src = A->in[idx[q]]; const size_t n8 = cnt[q] / 8;
                for (size_t c = (size_t)gw * 64 + lane; c < n8; c += (size_t)NGW * 64) { const f32x4 a = __builtin_nontemporal_load((const f32x4*)(src + c * 8)), b2 = __builtin_nontemporal_load((const f32x4*)(src + c * 8 + 4));
                    v4u o; o.x = pk2(a.x, a.y); o.y = pk2(a.z, a.w); o.z = pk2(b2.x, b2.y); o.w = pk2(b2.z, b2.w); __builtin_nontemporal_store(o, (v4u*)(dead + ((wpos + c * 8) % ((size_t)200 << 20)))); }
                wpos += cnt[q]; } }
#endif
        __syncthreads();
        for (int it = bid; it < DEPTH * NG; it += G) ssm_prep(A, it / NG, it % NG, lds, tid);
    }
    SEAM(0);
    for (int rep_ = 0; rep_ < REP_P1; ++rep_) if (ON(1) && IN(1)) {
        { KArgP A = kargs(); unsigned char* ws = A->ws; GWS; const float* x = A->in[I_X]; bf16* Hb = (bf16*)(ws + WS_H); pg8::ssq_t* ss = (pg8::ssq_t*)(ws + WS_CTL + CTL_SS);
          for (int m = gw; m < M; m += NGW) prenorm_row(x + (size_t)m * DM, Hb, ws + WS_H8, m, ss + m, lane); }
#pragma unroll 1
        for (int L = 0; L < DEPTH * REP_PE; ++L) { KArgP A = kargs(); unsigned char* ws = A->ws; GWS;
            pg8::Gemm g{(const bf16*)(ws + WS_PB) + (size_t)(L % DEPTH) * M * PLE, (const bf16*)(ws + WS_W + (size_t)(L % DEPTH) * W_LAYER + WO_PLE), M, DM, PLE};
            pg8::StaticOrder S; S.init(M, DM, G, bid);
            pg8::EpiB<0, false, false> E{(bf16*)(ws + WS_PE) + (size_t)(L % DEPTH) * M * DM, nullptr, nullptr, DM, nullptr, lds + 131072};
            pg8::gemm_phase<pg8::EpiB<0, false, false>, pg8::StaticOrder, GEMM_ALIGN, GEMM_SP2>(lds, g, S, E, wave);
        }
    }
    SEAM(1);
#pragma unroll 1
    for (int L = 0; L < DEPTH; ++L) {
        const int pb = 2 + PH_PER_LAYER * L;
#define LAYER_PTRS KArgP A = kargs(); unsigned char* ws = A->ws; GWS; unsigned char* wl = ws + WS_W + (size_t)L * W_LAYER; (void)wl; \
        unsigned char* H8c = ws + WS_H8 + (size_t)(L & 1) * M * DM; unsigned char* H8n = ws + WS_H8 + (size_t)((L & 1) ^ 1) * M * DM; (void)H8c; (void)H8n; \
        bf16* Hc = (bf16*)(ws + WS_H) + (size_t)(L & 1) * M * DM; bf16* Hn = (bf16*)(ws + WS_H) + (size_t)((L & 1) ^ 1) * M * DM; (void)Hc; (void)Hn;     \
        pg8::ssq_t* SSq = (pg8::ssq_t*)(ws + WS_CTL + CTL_SS); (void)SSq
        for (int rep_ = 0; rep_ < REP_IN; ++rep_) if (ON(3) && IN(pb + 0)) { LAYER_PTRS; stagger(bid, STAGGER_IN_NS);
            { pg8::Gemm g{Hc, (const bf16*)(wl + WO_IN), M, INW / 2, DM}; QkvuOrder S; S.init(M, INW / 2, G, bid);
              pg8::EpiIn E{SSq + (0 * 2 + L) * M, lds + 131072, (bf16*)(ws + WS_ACT)};
              pg8::gemm_phase<pg8::EpiIn, QkvuOrder, GEMM_ALIGN, GEMM_SP2>(lds, g, S, E, wave); }
            { pg8::Gemm g{(const bf16*)H8c, (const bf16*)(wl + WO_IN + (64u << 20)), M, INW / 2, DM / 2}; RotOrder S; S.init(M, INW / 2, G, bid);
              pg8::EpiGates E{SSq + (0 * 2 + L) * M, ws + WS_ACT + AO_SA, lds + 131072};
              pg8::gemm_phase<pg8::EpiGates, RotOrder, GEMM_ALIGN, GEMM_SP2>(lds, g, S, E, wave); }
        }
        SEAM(pb + 0);
        if (ON(4) && IN(pb + 1)) { LAYER_PTRS;
            { const bf16* Qb = (const bf16*)(ws + WS_ACT + AO_Q); const bf16* Kb = (const bf16*)(ws + WS_ACT + AO_K); const bf16* VPb = (const bf16*)(ws + WS_ACT + AO_VP); bf16* ATT = (bf16*)(ws + WS_ACT + AO_ATT);
              for (int rep_ = 0; rep_ < REP_ATT; ++rep_) for (int pu = bid; pu < BATCH * NH * 4; pu += G) { const int bh = pu >> 2, qp = pu & 3, b = bh >> 4, h = bh & 15;
                  attn_wave(Qb, Kb, VPb, ATT, b, h, 256 * (7 - qp) + 32 * wave, lane);
                  attn_wave(Qb, Kb, VPb, ATT, b, h, 256 * qp + 32 * wave, lane); } }
            __syncthreads();
            { unsigned char* sl = ws + WS_SSM + (size_t)L * SSM_LAYER; const float* dsk = A->in[I_DSKIP] + L * SW;
              for (int rep_ = 0; rep_ < REP_SSM; ++rep_) for (int su = bid; su < BATCH * NG; su += G) { const int b = su >> 7, g = su & 127;
                  ssm_unit(b, g, (const bf16*)(ws + WS_ACT + AO_U), (const bf16*)(sl + SO_T) + (size_t)g * 65536, (const bf16*)(sl + SO_E) + (size_t)g * 32768, (const bf16*)(sl + SO_F) + (size_t)g * 32768,
                           (const float*)(sl + SO_L16) + g * 128, dsk, (bf16*)(ws + WS_ACT + AO_Y), ws + WS_Y8, lds, wave, lane, rep_ == 0 ? 0 : SSM_PROBE_MODE); } }
        }
        SEAM(pb + 1);
        for (int rep_ = 0; rep_ < REP_GB; ++rep_) if (ON(5) && IN(pb + 2)) {
            { LAYER_PTRS; pg8::Gemm g{(const bf16*)(ws + WS_Y8), (const bf16*)(wl + WO_GLU), M, SW, SW / 2}; pg8::StaticOrder S; S.init(M, SW, G, bid);
              pg8::EpiB<2, true, true, true> E{(bf16*)(ws + WS_ACT + AO_SSM), (const bf16*)(ws + WS_ACT + AO_Y), nullptr, SW, nullptr, lds + 131072};
              pg8::gemm_phase<pg8::EpiB<2, true, true, true>, pg8::StaticOrder, GEMM_ALIGN, GEMM_SP2>(lds, g, S, E, wave); }
            { LAYER_PTRS; pg8::Gemm g{(const bf16*)(ws + WS_ACT + AO_ATT), (const bf16*)(wl + WO_BRA), M, DM, AW}; RotOrder S; S.init(M, DM, G, bid);
              pg8::EpiB<3, false, false> E{(bf16*)(ws + WS_ACT + AO_TMP), (const bf16*)(ws + WS_ACT + AO_SA), nullptr, DM, nullptr, lds + 131072};
              pg8::gemm_phase<pg8::EpiB<3, false, false>, RotOrder, GEMM_ALIGN, GEMM_SP2>(lds, g, S, E, wave); }
        }
        SEAM(pb + 2);
        for (int rep_ = 0; rep_ < REP_BRS; ++rep_) if (ON(6) && IN(pb + 3)) { LAYER_PTRS;
            pg8::Gemm g{(const bf16*)(ws + WS_ACT + AO_SSM), (const bf16*)(wl + WO_BRS), M, DM, SW}; RotOrder S; S.init(M, DM, G, bid);
            pg8::EpiB<4, true, false> E{(bf16*)(ws + WS_ACT + AO_MRG), (const bf16*)(ws + WS_ACT + AO_TMP), (const bf16*)(ws + WS_ACT + AO_SS), DM, nullptr, lds + 131072};
            pg8::gemm_phase<pg8::EpiB<4, true, false>, RotOrder, GEMM_ALIGN, GEMM_SP2>(lds, g, S, E, wave);
        }
        SEAM(pb + 3);
        if (ON(7) && IN(pb + 4)) { LAYER_PTRS;
            pg8::Gemm g{(const bf16*)(ws + WS_ACT + AO_MRG), (const bf16*)(wl + WO_O), M, DM, DM}; RotOrder S; S.init(M, DM, G, bid);
            pg8::EpiRes<false> E{Hc, Hc, nullptr, nullptr, SSq + (1 * 2 + L) * M, 1, nullptr, lds + 131072};
            pg8::gemm_phase<pg8::EpiRes<false>, RotOrder, GEMM_ALIGN, GEMM_SP2>(lds, g, S, E, wave);
        }
        SEAM(pb + 4);
        for (int rep_ = 0; rep_ < REP_FF1; ++rep_) if (ON(9) && IN(pb + 5)) { LAYER_PTRS; stagger(bid, STAGGER_FF1_NS);
            pg8::Gemm g{Hc, (const bf16*)(wl + WO_FF1), M, DFF, DM}; RotOrder S; S.init(M, DFF, G, bid);
            pg8::EpiB<1, true, false> E{(bf16*)(ws + WS_MID), nullptr, nullptr, DFF, SSq + (1 * 2 + L) * M, lds + 131072};
#if defined(PROBE_SPLIT_FF1)
            S.iend = 4;
            pg8::gemm_phase<pg8::EpiB<1, true, false>, RotOrder, GEMM_ALIGN, GEMM_SP2>(lds, g, S, E, wave);
            { KArgP A_ = kargs(); XcdBarrier b_; b_.bar = (unsigned*)(A_->ws + WS_CTL) + CW_BAR; b_.x = xb_xcc_id(); b_.st = MISC + 8; b_.t0 = (wave_s == 0) && (pg8::lane_id() == 0); xcd_barrier(b_); }
            S.ibeg = 4; S.iend = 8;
#endif
            pg8::gemm_phase<pg8::EpiB<1, true, false>, RotOrder, GEMM_ALIGN, GEMM_SP2>(lds, g, S, E, wave);
        }
        SEAM(pb + 5);
#if defined(PROBE_FF2X)
        if (ON(10) && IN(pb + 6)) { LAYER_PTRS;
            pg8::Gemm g{(const bf16*)(ws + WS_MID), (const bf16*)(wl + WO_FF2), M, DM, DFF}; pg8::StaticOrder S; S.init(M, DM, G, bid);
            pg8::EpiB<0, false, false> E{(bf16*)(ws + WS_ACT + AO_TMP), nullptr, nullptr, DM, nullptr, lds + 131072};
            pg8::gemm_phase<pg8::EpiB<0, false, false>, pg8::StaticOrder, GEMM_ALIGN, GEMM_SP2>(lds, g, S, E, wave); }
#endif
#if defined(PROBE_L2X)
        if (ON(10) && IN(pb + 6)) { LAYER_PTRS;
            pg8::Gemm g{Hc, (const bf16*)(wl + WO_O), M, DM, -DM}; pg8::StaticOrder S; S.init(M, DM, G, bid);
            pg8::EpiB<0, false, false> E{(bf16*)(ws + WS_ACT + AO_TMP), nullptr, nullptr, DM, nullptr, lds + 131072};
            pg8::gemm_phase<pg8::EpiB<0, false, false>, pg8::StaticOrder, GEMM_ALIGN, GEMM_SP2>(lds, g, S, E, wave); }
#endif
#if defined(PROBE_OX)
        if (ON(10) && IN(pb + 6)) { LAYER_PTRS;
            pg8::Gemm g{Hc, (const bf16*)(wl + WO_O), M, DM, DM}; pg8::StaticOrder S; S.init(M, DM, G, bid);
            pg8::EpiB<0, false, false> E{(bf16*)(ws + WS_ACT + AO_TMP), nullptr, nullptr, DM, nullptr, lds + 131072};
            pg8::gemm_phase<pg8::EpiB<0, false, false>, pg8::StaticOrder, GEMM_ALIGN, GEMM_SP2>(lds, g, S, E, wave); }
#endif
        if (ON(10) && IN(pb + 6)) { LAYER_PTRS;
            pg8::Gemm g{(const bf16*)(ws + WS_MID), (const bf16*)(wl + WO_FF2), M, DM, DFF}; FF2_ORDER S; S.init(M, DM, G, bid);
            pg8::EpiRes<false> E{Hc, Hc, nullptr, nullptr, SSq + (2 * 2 + L) * M, 1, H8c, lds + 131072};
            pg8::gemm_phase<pg8::EpiRes<false>, FF2_ORDER, GEMM_ALIGN, GEMM_SP2>(lds, g, S, E, wave);
        }
        SEAM(pb + 6);
        if (ON(12) && IN(pb + 7)) { LAYER_PTRS; const int Ln = (L + 1 < DEPTH) ? L + 1 : L;
            pg8::Gemm g{(const bf16*)H8c, (const bf16*)(wl + WO_PG), M, DM, DM / 2};     RotOrder S; S.init(M, DM, G, bid);
            pg8::EpiRes<true> E{Hc, Hn, (const bf16*)(ws + WS_PE) + (size_t)L * M * DM, SSq + (2 * 2 + L) * M, SSq + (0 * 2 + Ln) * M, (L + 1 < DEPTH) ? 1 : 0, (L + 1 < DEPTH) ? H8n : nullptr, lds + 131072};
            pg8::gemm_phase<pg8::EpiRes<true>, RotOrder, GEMM_ALIGN, GEMM_SP2>(lds, g, S, E, wave);
        }
        SEAM(pb + 7);
    }
    if (ON(13) && IN(N_PHASES - 1)) { KArgP A = kargs(); unsigned char* ws = A->ws; GWS; const bf16* H = (const bf16*)(ws + WS_H) + (size_t)(DEPTH & 1) * M * DM; const float* gf = A->in[I_GFIN]; float* out = A->out;
        for (int m = gw; m < M; m += NGW) rms_row_f32(H, m, gf, out + (size_t)m * DM, lane); }
#if defined(PROBE_SKEW)
    { KArgP A_ = kargs(); XcdBarrier b_; b_.bar = (unsigned*)(A_->ws + WS_CTL) + CW_BAR; b_.x = xb_xcc_id(); b_.st = MISC + 8; b_.t0 = (wave_s == 0) && (pg8::lane_id() == 0); if (A_->ph_hi - A_->ph_lo > 1) { PROBE_SKEW_STAMP(N_PHASES - 1); xcd_barrier(b_); } }
    { KArgP A = kargs(); if (blockIdx.x == 0 && wave_s == 0 && pg8::lane_id() == 0 && A->ph_hi - A->ph_lo > 1) { unsigned long long* pk = (unsigned long long*)(A->ws + WS_CTL + 131072); unsigned long long tot = 0;
        for (int s_ = 0; s_ < N_PHASES; ++s_) { const unsigned long long fn = __hip_atomic_load(pk + 2 * s_, __ATOMIC_RELAXED, __HIP_MEMORY_SCOPE_AGENT), l_ = __hip_atomic_load(pk + 2 * s_ + 1, __ATOMIC_RELAXED, __HIP_MEMORY_SCOPE_AGENT); if (l_ != 0ull && ((PROBE_SKEW_MASK >> s_) & 1)) tot += l_ - ~fn; }
        const unsigned long long t0 = __builtin_amdgcn_s_memrealtime(); while (__builtin_amdgcn_s_memrealtime() - t0 < tot * PROBE_SKEW) __builtin_amdgcn_s_sleep(8); } }
#endif
#undef IN
#undef SEAM
}

extern "C" void kernel_launch(void* const* d_in, const int* in_sizes, int n_in, void* d_out, int out_size, void* d_ws, size_t ws_size, hipStream_t stream) {
    static int grid = 0;
    if (grid == 0) {
        if (n_in != 23 || in_sizes[0] != M * DM || out_size != M * DM || ws_size < WS_END) { fprintf(stderr, "kernel_launch: unexpected shapes / workspace (n_in %d, ws %zu, need %zu); nothing launched\n", n_in, ws_size, (size_t)WS_END); grid = -1; return; }
        int dev = 0, cus = 0, per_cu = 0;
        if (hipGetDevice(&dev) != hipSuccess || hipDeviceGetAttribute(&cus, hipDeviceAttributeMultiprocessorCount, dev) != hipSuccess) { grid = -1; return; }
        if (hipFuncSetAttribute((const void*)fwd, hipFuncAttributeMaxDynamicSharedMemorySize, LDS_BYTES) != hipSuccess) { fprintf(stderr, "kernel_launch: hipFuncSetAttribute failed\n"); grid = -1; return; }
        if (hipOccupancyMaxActiveBlocksPerMultiprocessor(&per_cu, (const void*)fwd, NWAVES * 64, LDS_BYTES) != hipSuccess || per_cu < 1) fprintf(stderr, "kernel_launch: note: occupancy query says %d workgroups per CU\n", per_cu);
        (void)hipGetLastError();
        grid = cus;
    }
    if (grid < 0) return;
    if (hipMemsetAsync((char*)d_ws + WS_CTL, 0, CTL_ZERO_BYTES, stream) != hipSuccess) return;
    Args a{};
    for (int i = 0; i < 23; ++i) a.in[i] = (const float*)d_in[i];
    a.out = (float*)d_out; a.ws = (unsigned char*)d_ws;
#if MK_N_LAUNCHES == 1
    a.ph_lo = 0; a.ph_hi = N_PHASES; a.li = 0;
    hipLaunchKernelGGL(fwd, dim3(grid), dim3(NWAVES * 64), LDS_BYTES, stream, a);
#else
    for (int ph = 0; ph < N_PHASES; ++ph) { a.ph_lo = ph; a.ph_hi = ph + 1; a.li = ph;
        hipLaunchKernelGGL(fwd, dim3(grid), dim3(NWAVES * 64), LDS_BYTES, stream, a); }
#endif
}
```
